# Optimizing an MI355X kernel written in HIP

```python
import math
import jax, jax.numpy as jnp
from jax import lax
import numpy as np


D_MODEL = 1024
BATCH = 8
SEQ = 4096
DEPTH = 2

N_A = DEPTH // 2
N_B = DEPTH - N_A

DIFF_HEADS = 8
DIFF_HEAD_DIM = 64
DIFF_V_DIM = 2 * DIFF_HEAD_DIM
DIFF_QK_WIDTH = DIFF_HEADS * 2 * DIFF_HEAD_DIM
DIFF_V_WIDTH = DIFF_HEADS * DIFF_V_DIM

MLA_HEADS = 8
MLA_NOPE = 128
MLA_ROPE = 64
MLA_V = 128
Q_LORA = 384
KV_LORA = 256

D_FF = 4 * D_MODEL

ROPE_THETA = 10000.0
EPS = 1e-6
SUBLN_EPS = 1e-5
Q_BLOCK = 128

kernel_name = "yoco_diffattn_mla_hybrid"


def rms_norm(x, g, eps=EPS):
    xf = x.astype(jnp.float32)
    y = xf * lax.rsqrt(jnp.mean(xf * xf, axis=-1, keepdims=True) + eps)
    return (y * g.astype(jnp.float32)).astype(x.dtype)


def rope_tables(seq, dim):
    pos = jnp.arange(seq, dtype=jnp.float32)
    inv_freq = ROPE_THETA ** (-jnp.arange(0, dim, 2, dtype=jnp.float32) / dim)
    ang = pos[:, None] * inv_freq[None, :]
    return jnp.cos(ang), jnp.sin(ang)


def apply_rope(x, cos, sin):
    half = x.shape[-1] // 2
    x1, x2 = x[..., :half], x[..., half:]
    c = cos[None, :, None, :].astype(x.dtype)
    s = sin[None, :, None, :].astype(x.dtype)
    return jnp.concatenate([x1 * c - x2 * s, x2 * c + x1 * s], axis=-1)


def causal_mask(i, seq):
    q_pos = i * Q_BLOCK + jnp.arange(Q_BLOCK)
    k_pos = jnp.arange(seq)
    return k_pos[None, :] <= q_pos[:, None]


def diff_attention(hn, w_qkv, w_o, lq1, lk1, lq2, lk2, subln_g, lambda_init, cos, sin):
    B, S, _ = hn.shape
    H, d = DIFF_HEADS, DIFF_HEAD_DIM
    qkv = hn @ w_qkv
    q, k, v = jnp.split(qkv, [DIFF_QK_WIDTH, 2 * DIFF_QK_WIDTH], axis=-1)
    q = apply_rope(q.reshape(B, S, 2 * H, d), cos, sin).reshape(B, S, H, 2, d)
    k = apply_rope(k.reshape(B, S, 2 * H, d), cos, sin).reshape(B, S, H, 2, d)
    v = v.reshape(B, S, H, DIFF_V_DIM)
    lam = (jnp.exp(jnp.sum(lq1.astype(jnp.float32) * lk1.astype(jnp.float32)))
           - jnp.exp(jnp.sum(lq2.astype(jnp.float32) * lk2.astype(jnp.float32)))
           + lambda_init)
    scale = d ** -0.5
    nb = S // Q_BLOCK
    qb = q.reshape(B, nb, Q_BLOCK, H, 2, d).transpose(1, 0, 2, 3, 4, 5)

    def block(args):
        q_blk, i = args
        s = jnp.einsum('bqhcd,bkhcd->bhcqk', q_blk, k).astype(jnp.float32) * scale
        s = jnp.where(causal_mask(i, S)[None, None, None], s, -jnp.inf)
        p = jax.nn.softmax(s, axis=-1)
        a = p[:, :, 0] - lam * p[:, :, 1]
        return jnp.einsum('bhqk,bkhe->bqhe', a.astype(v.dtype), v)

    o = lax.map(block, (qb, jnp.arange(nb)))
    o = o.transpose(1, 0, 2, 3, 4).reshape(B, S, H, DIFF_V_DIM)
    o = rms_norm(o, subln_g, SUBLN_EPS) * (1.0 - lambda_init)
    return o.reshape(B, S, DIFF_V_WIDTH) @ w_o


def mla_shared_kv(h, kv_in_norm_g, w_dkv, kv_norm_g, w_ukv, cos, sin):
    B, S, _ = h.shape
    hn = rms_norm(h, kv_in_norm_g)
    ckv = hn @ w_dkv
    c, k_rope = ckv[..., :KV_LORA], ckv[..., KV_LORA:]
    c = rms_norm(c, kv_norm_g)
    kv = (c @ w_ukv).reshape(B, S, MLA_HEADS, MLA_NOPE + MLA_V)
    k_nope, v = kv[..., :MLA_NOPE], kv[..., MLA_NOPE:]
    k_rope = apply_rope(k_rope[:, :, None, :], cos, sin)[:, :, 0, :]
    return k_nope, k_rope, v


def mla_attention(hn, w_dq, q_norm_g, w_uq, w_o, k_nope, k_rope, v, cos, sin):
    B, S, _ = hn.shape
    H = MLA_HEADS
    cq = rms_norm(hn @ w_dq, q_norm_g)
    q = (cq @ w_uq).reshape(B, S, H, MLA_NOPE + MLA_ROPE)
    q_nope = q[..., :MLA_NOPE]
    q_rope = apply_rope(q[..., MLA_NOPE:], cos, sin)
    scale = (MLA_NOPE + MLA_ROPE) ** -0.5
    nb = S // Q_BLOCK
    qn_b = q_nope.reshape(B, nb, Q_BLOCK, H, MLA_NOPE).transpose(1, 0, 2, 3, 4)
    qr_b = q_rope.reshape(B, nb, Q_BLOCK, H, MLA_ROPE).transpose(1, 0, 2, 3, 4)

    def block(args):
        qn, qr, i = args
        s = (jnp.einsum('bqhd,bkhd->bhqk', qn, k_nope)
             + jnp.einsum('bqhr,bkr->bhqk', qr, k_rope)).astype(jnp.float32) * scale
        s = jnp.where(causal_mask(i, S)[None, None], s, -jnp.inf)
        p = jax.nn.softmax(s, axis=-1)
        return jnp.einsum('bhqk,bkhe->bqhe', p.astype(v.dtype), v)

    o = lax.map(block, (qn_b, qr_b, jnp.arange(nb)))
    o = o.transpose(1, 0, 2, 3, 4).reshape(B, S, H * MLA_V)
    return o @ w_o


def sq_relu_mlp(hn, w_up, w_down):
    return jnp.square(jax.nn.relu(hn @ w_up)) @ w_down


def _w(key, shape, fan_in):
    return jax.random.normal(key, shape, jnp.float32) * fan_in ** -0.5


def _g(key, shape):
    return 1.0 + 0.02 * jax.random.normal(key, shape, jnp.float32)


def setup_inputs(seed: int = 0) -> dict:
    key = jax.random.key(seed)
    ks = jax.random.split(key, 24)
    return {
        "x": jax.random.normal(ks[0], (BATCH, SEQ, D_MODEL), jnp.float32),
        "attn_norm_g": _g(ks[1], (DEPTH, D_MODEL)),
        "w_qkv_a": _w(ks[2], (N_A, D_MODEL, 2 * DIFF_QK_WIDTH + DIFF_V_WIDTH), D_MODEL),
        "lambda_q1": 0.1 * jax.random.normal(ks[3], (N_A, DIFF_HEAD_DIM), jnp.float32),
        "lambda_k1": 0.1 * jax.random.normal(ks[4], (N_A, DIFF_HEAD_DIM), jnp.float32),
        "lambda_q2": 0.1 * jax.random.normal(ks[5], (N_A, DIFF_HEAD_DIM), jnp.float32),
        "lambda_k2": 0.1 * jax.random.normal(ks[6], (N_A, DIFF_HEAD_DIM), jnp.float32),
        "subln_g": _g(ks[7], (N_A, DIFF_V_DIM)),
        "w_o_a": _w(ks[8], (N_A, DIFF_V_WIDTH, D_MODEL), DIFF_V_WIDTH),
        "kv_in_norm_g": _g(ks[9], (D_MODEL,)),
        "w_dkv": _w(ks[10], (D_MODEL, KV_LORA + MLA_ROPE), D_MODEL),
        "kv_norm_g": _g(ks[11], (KV_LORA,)),
        "w_ukv": _w(ks[12], (KV_LORA, MLA_HEADS * (MLA_NOPE + MLA_V)), KV_LORA),
        "w_dq": _w(ks[13], (N_B, D_MODEL, Q_LORA), D_MODEL),
        "q_norm_g": _g(ks[14], (N_B, Q_LORA)),
        "w_uq": _w(ks[15], (N_B, Q_LORA, MLA_HEADS * (MLA_NOPE + MLA_ROPE)), Q_LORA),
        "w_o_b": _w(ks[16], (N_B, MLA_HEADS * MLA_V, D_MODEL), MLA_HEADS * MLA_V),
        "mlp_norm_g": _g(ks[17], (DEPTH, D_MODEL)),
        "w_up": _w(ks[18], (DEPTH, D_MODEL, D_FF), D_MODEL),
        "w_down": _w(ks[19], (DEPTH, D_FF, D_MODEL), D_FF),
        "final_norm_g": _g(ks[20], (D_MODEL,)),
    }


def reference(x, attn_norm_g, w_qkv_a, lambda_q1, lambda_k1, lambda_q2, lambda_k2, subln_g, w_o_a,
              kv_in_norm_g, w_dkv, kv_norm_g, w_ukv, w_dq, q_norm_g, w_uq, w_o_b,
              mlp_norm_g, w_up, w_down, final_norm_g):
    S = x.shape[1]
    cos_a, sin_a = rope_tables(S, DIFF_HEAD_DIM)
    cos_b, sin_b = rope_tables(S, MLA_ROPE)
    h = x
    k_nope = k_rope = v = None
    for l in range(DEPTH):
        if l < N_A:
            lambda_init = 0.8 - 0.6 * math.exp(-0.3 * l)
            hn = rms_norm(h, attn_norm_g[l])
            h = h + diff_attention(hn, w_qkv_a[l], w_o_a[l], lambda_q1[l], lambda_k1[l],
                                   lambda_q2[l], lambda_k2[l], subln_g[l], lambda_init,
                                   cos_a, sin_a)
        else:
            if l == N_A:
                k_nope, k_rope, v = mla_shared_kv(h, kv_in_norm_g, w_dkv, kv_norm_g, w_ukv,
                                                  cos_b, sin_b)
            j = l - N_A
            hn = rms_norm(h, attn_norm_g[l])
            h = h + mla_attention(hn, w_dq[j], q_norm_g[j], w_uq[j], w_o_b[j],
                                  k_nope, k_rope, v, cos_b, sin_b)
        h = h + sq_relu_mlp(rms_norm(h, mlp_norm_g[l]), w_up[l], w_down[l])
    return rms_norm(h, final_norm_g)
```

```cpp
#include <hip/hip_runtime.h>
#include <hip/hip_cooperative_groups.h>
#include <cstdio>
#include <cstdint>
#include <cmath>
namespace cg = cooperative_groups;
#define MK_SINGLE 1
namespace pg8 {
#define PG8_LAS __attribute__((address_space(3)))
typedef unsigned short bf16_t;
typedef short bf16x8 __attribute__((ext_vector_type(8)));
typedef float f32x4 __attribute__((ext_vector_type(4)));
typedef unsigned u32x4 __attribute__((ext_vector_type(4)));
constexpr int BM = 256, BK = 64, HALF = 128, HTB = HALF * BK * 2  , STAGE_BYTES = 8 * HTB, NXCD = 8, WGM = 8;

__host__ __device__ __forceinline__ int lds_byte(int r, int c) { const int st = (r >> 4) * 2 + (c >> 5), rr = r & 15, cc = c & 31, ob = rr * 64 + cc * 2; return st * 1024 + (ob ^ (((ob >> 9) & 1) << 5)); }
__host__ __device__ __forceinline__ void stage_rc(int b, int& R, int& C) { const int st = b / 1024, sb = b % 1024, swz = sb ^ (((sb >> 9) & 1) << 5); R = (st >> 1) * 16 + swz / 64; C = (st & 1) * 32 + (swz % 64) / 2; }
__host__ __device__ __forceinline__ int perm32(int rho) { const int n = rho >> 4, i = rho & 15; return 8 * (i >> 2) + 4 * n + (i & 3); }

struct Unit { int pm, pn; };
struct Gemm { const bf16_t* A; const bf16_t* Bt; int M, N, K; };

struct StaticOrder {
    int nM, nN, nwg, G, c, rep = 1;
    __host__ __device__ void init(int M, int N, int G_, int c_) { nM = M / BM; nN = N / BM; nwg = nM * nN; G = G_; c = c_; }
    __host__ __device__ bool next(int i, Unit& u) const {
        const long L = (long)i * G + c; if (L >= (long)nwg * rep) return false;
        int wgid = (int)(L >= nwg ? L - nwg : L); { const int q = nwg / NXCD, r = nwg % NXCD, xcd = wgid % NXCD, off = wgid / NXCD; wgid = (xcd < r ? xcd * (q + 1) : r * (q + 1) + (xcd - r) * q) + off; }
        const int nig = WGM * nN, gid = wgid / nig, fm = gid * WGM, gsz = (nM - fm) < WGM ? (nM - fm) : WGM;
        u.pm = fm + ((wgid % nig) % gsz); u.pn = (wgid % nig) / gsz; return true;
    }
    __device__ __forceinline__ void a_ready(const Unit&) const {}
    __device__ __forceinline__ void done(const Unit&) const {}
};

__device__ __forceinline__ unsigned cvt_pk_bf16(float lo, float hi) { unsigned r; asm volatile("v_cvt_pk_bf16_f32 %0, %1, %2" : "=v"(r) : "v"(lo), "v"(hi)); return r; }

template <class Epi, class Sched, bool ALIGN_EPI = false, bool SP2 = false>
__device__ __forceinline__ void gemm_phase(PG8_LAS unsigned char* lds, const Gemm g, const Sched& S, const Epi& E) {
    const int tid = threadIdx.x, wid = __builtin_amdgcn_readfirstlane(tid >> 6), lane = tid & 63, wr = wid >> 2, wc = wid & 3, fr = lane & 15, fq = lane >> 4;
    const int K = g.K, nt = K / BK;
    unsigned voffA[2], voffB[2];
#pragma unroll
    for (int i = 0; i < 2; ++i) { int R, C; stage_rc(tid * 16 + i * 8192, R, C); const int Rb = Epi::PERM ? ((R & ~31) + perm32(R & 31)) : R;
        voffA[i] = (unsigned)(R * K + C) * 2u; voffB[i] = (unsigned)(Rb * K + C) * 2u; }
    const size_t kstep = (size_t)(BK * 2);
    const size_t hstep = (size_t)HALF * K * 2;
    const size_t tstep = 2 * hstep;
    const unsigned ldsw = (unsigned)wid * 1024u;
    const int aoff = lds_byte(wr * 64 + fr, fq * 8), boff = lds_byte(wc * 32 + fr, fq * 8);
#define PG8_SA(b, h) (((b) * 2 + (h)) * HTB)
#define PG8_SB(b, h) ((4 + (b) * 2 + (h)) * HTB)
#define PG8_STAGE(bufoff, gbase, voff) do { _Pragma("unroll") for (int _i = 0; _i < 2; ++_i) \
        __builtin_amdgcn_global_load_lds((const unsigned*)((const char*)(gbase) + (voff)[_i]), (PG8_LAS unsigned*)(lds + (bufoff) + ldsw + _i * 8192), 16, 0, 0); } while (0)
#define PG8_LDA(dst, b, h) do { _Pragma("unroll") for (int m = 0; m < 4; ++m) _Pragma("unroll") for (int k = 0; k < 2; ++k) dst[m][k] = *(const PG8_LAS bf16x8*)(lds + PG8_SA(b, h) + aoff + m * 2048 + k * 1024); } while (0)
#define PG8_LDB(dst, b, h) do { _Pragma("unroll") for (int n = 0; n < 2; ++n) _Pragma("unroll") for (int k = 0; k < 2; ++k) dst[n][k] = *(const PG8_LAS bf16x8*)(lds + PG8_SB(b, h) + boff + n * 2048 + k * 1024); } while (0)
#define PG8_MMA(ai, bj, At, Bt) do { __builtin_amdgcn_s_setprio(1); _Pragma("unroll") for (int m = 0; m < 4; ++m) _Pragma("unroll") for (int n = 0; n < 2; ++n) _Pragma("unroll") for (int k = 0; k < 2; ++k) \
        acc[ai][bj][m][n] = __builtin_amdgcn_mfma_f32_16x16x32_bf16(Bt[n][k], At[m][k], acc[ai][bj][m][n], 0, 0, 0); __builtin_amdgcn_s_setprio(0); } while (0)
#define PG8_WAIT_V(n) asm volatile("s_waitcnt vmcnt(" #n ")" ::: "memory")
#define PG8_WAIT_L(n) asm volatile("s_waitcnt lgkmcnt(" #n ")" ::: "memory")
#define PG8_BAR __builtin_amdgcn_s_barrier()
#define PG8_SCHED __builtin_amdgcn_sched_barrier(0)
    Unit cur, nxt; int ui = 0;
    if (!S.next(0, cur)) return;
    f32x4 acc[2][2][4][2];
#pragma unroll
    for (int a = 0; a < 2; ++a)
#pragma unroll
        for (int b = 0; b < 2; ++b)
#pragma unroll
            for (int m = 0; m < 4; ++m)
#pragma unroll
                for (int n = 0; n < 2; ++n) acc[a][b][m][n] = (f32x4){0.f, 0.f, 0.f, 0.f};
    bf16x8 At[4][2], B0[2][2], B1[2][2];
    const char* cA = (const char*)g.A + (size_t)cur.pm * tstep; const char* cB = (const char*)g.Bt + (size_t)cur.pn * tstep;
    S.a_ready(cur);
    if constexpr (SP2) {
        PG8_STAGE(PG8_SB(0, 0), cB, voffB); PG8_STAGE(PG8_SB(0, 1), cB + hstep, voffB); PG8_STAGE(PG8_SA(0, 0), cA, voffA); PG8_STAGE(PG8_SA(0, 1), cA + hstep, voffA);
        if (wr == 1) PG8_BAR;
        PG8_WAIT_V(2); PG8_BAR;
        PG8_STAGE(PG8_SB(1, 0), cB + kstep, voffB); PG8_STAGE(PG8_SA(1, 0), cA + kstep, voffA); PG8_STAGE(PG8_SB(1, 1), cB + hstep + kstep, voffB);
        PG8_WAIT_V(6); PG8_BAR;
    } else {
        PG8_STAGE(PG8_SB(0, 0), cB, voffB); PG8_STAGE(PG8_SA(0, 0), cA, voffA); PG8_STAGE(PG8_SB(0, 1), cB + hstep, voffB); PG8_STAGE(PG8_SA(0, 1), cA + hstep, voffA);
        if (wr == 1) PG8_BAR;
        PG8_WAIT_V(4); PG8_BAR;
        PG8_STAGE(PG8_SB(1, 0), cB + kstep, voffB); PG8_STAGE(PG8_SA(1, 0), cA + kstep, voffA); PG8_STAGE(PG8_SB(1, 1), cB + hstep + kstep, voffB);
        PG8_WAIT_V(6); PG8_BAR;
    }
    for (;;) {
        const bool has_next = S.next(ui + 1, nxt);
        const char* nA = has_next ? (const char*)g.A + (size_t)nxt.pm * tstep : cA; const char* nB = has_next ? (const char*)g.Bt + (size_t)nxt.pn * tstep : cB;
#pragma unroll 1
        for (int t = 0; t < nt; t += 2) {
            const bool last = (t == nt - 2);
            const char* a1 = cA + (size_t)(t + 1) * kstep;
            const char* a2 = last ? nA : cA + (size_t)(t + 2) * kstep; const char* b2 = last ? nB : cB + (size_t)(t + 2) * kstep;
            const char* a3 = a2 + kstep; const char* b3 = b2 + kstep;
            if (last && has_next) S.a_ready(nxt);
            if constexpr (SP2) {
            PG8_LDB(B0, 0, 0); PG8_LDB(B1, 0, 1); PG8_SCHED; PG8_LDA(At, 0, 0); PG8_STAGE(PG8_SA(1, 1), a1 + hstep, voffA);
            PG8_WAIT_V(8); PG8_WAIT_L(0); PG8_BAR; PG8_MMA(0, 0, At, B0); PG8_MMA(0, 1, At, B1); PG8_BAR; PG8_SCHED;
            PG8_LDA(At, 0, 1); PG8_STAGE(PG8_SB(0, 0), b2, voffB); PG8_STAGE(PG8_SB(0, 1), b2 + hstep, voffB); PG8_STAGE(PG8_SA(0, 0), a2, voffA);
            PG8_WAIT_V(8); PG8_WAIT_L(0); PG8_BAR; PG8_MMA(1, 0, At, B0); PG8_MMA(1, 1, At, B1); PG8_BAR; PG8_SCHED;
            PG8_LDB(B0, 1, 0); PG8_LDB(B1, 1, 1); PG8_SCHED; PG8_LDA(At, 1, 0); PG8_STAGE(PG8_SA(0, 1), a2 + hstep, voffA);
            PG8_WAIT_V(8); PG8_WAIT_L(0); PG8_BAR; PG8_MMA(0, 0, At, B0); PG8_MMA(0, 1, At, B1); PG8_BAR; PG8_SCHED;
            PG8_LDA(At, 1, 1); PG8_STAGE(PG8_SB(1, 0), b3, voffB); PG8_STAGE(PG8_SB(1, 1), b3 + hstep, voffB); PG8_STAGE(PG8_SA(1, 0), a3, voffA);
            PG8_WAIT_V(8); PG8_WAIT_L(0); PG8_BAR; PG8_MMA(1, 0, At, B0); PG8_MMA(1, 1, At, B1); PG8_BAR; PG8_SCHED;
            } else {
            PG8_LDB(B0, 0, 0); PG8_SCHED; PG8_LDA(At, 0, 0); PG8_STAGE(PG8_SA(1, 1), a1 + hstep, voffA);
            PG8_WAIT_L(8); PG8_BAR; PG8_WAIT_L(0); PG8_MMA(0, 0, At, B0); PG8_BAR; PG8_SCHED;
            PG8_LDB(B1, 0, 1); PG8_STAGE(PG8_SB(0, 0), b2, voffB);
            PG8_BAR; PG8_WAIT_L(0); PG8_MMA(0, 1, At, B1); PG8_BAR;
            PG8_LDA(At, 0, 1); PG8_STAGE(PG8_SA(0, 0), a2, voffA);
            PG8_BAR; PG8_WAIT_L(0); PG8_MMA(1, 0, At, B0); PG8_BAR; PG8_SCHED;
            PG8_STAGE(PG8_SB(0, 1), b2 + hstep, voffB);
            PG8_WAIT_V(6); PG8_BAR; PG8_MMA(1, 1, At, B1); PG8_BAR;
            PG8_LDB(B0, 1, 0); PG8_SCHED; PG8_LDA(At, 1, 0); PG8_STAGE(PG8_SA(0, 1), a2 + hstep, voffA);
            PG8_WAIT_L(8); PG8_BAR; PG8_WAIT_L(0); PG8_MMA(0, 0, At, B0); PG8_BAR; PG8_SCHED;
            PG8_LDB(B1, 1, 1); PG8_STAGE(PG8_SB(1, 0), b3, voffB);
            PG8_BAR; PG8_WAIT_L(0); PG8_MMA(0, 1, At, B1); PG8_BAR;
            PG8_LDA(At, 1, 1); PG8_STAGE(PG8_SA(1, 0), a3, voffA);
            PG8_BAR; PG8_WAIT_L(0); PG8_MMA(1, 0, At, B0); PG8_BAR; PG8_SCHED;
            PG8_STAGE(PG8_SB(1, 1), b3 + hstep, voffB);
            PG8_WAIT_V(6); PG8_BAR; PG8_MMA(1, 1, At, B1); PG8_BAR;
            }
        }
        if constexpr (ALIGN_EPI) { if (wr == 0) PG8_BAR; }
        if constexpr (!Epi::AFTER_DRAIN) { E(acc, cur, wr, wc, fr, fq); S.done(cur); }
        if (!has_next) break;
#pragma unroll
        for (int a = 0; a < 2; ++a)
#pragma unroll
            for (int b = 0; b < 2; ++b)
#pragma unroll
                for (int m = 0; m < 4; ++m)
#pragma unroll
                    for (int n = 0; n < 2; ++n) acc[a][b][m][n] = (f32x4){0.f, 0.f, 0.f, 0.f};
        cur = nxt; cA = nA; cB = nB; ++ui;
        if constexpr (ALIGN_EPI) { if (wr == 1) PG8_BAR; }
    }
    PG8_WAIT_V(0);
    if constexpr (!ALIGN_EPI) { if (wr == 0) PG8_BAR; }
    PG8_BAR;
    if constexpr (Epi::AFTER_DRAIN) { E.fused(acc, cur, wr, wc, fr, fq, lds, wid, lane); S.done(cur); }
#undef PG8_SA
#undef PG8_SB
#undef PG8_STAGE
#undef PG8_LDA
#undef PG8_LDB
#undef PG8_MMA
#undef PG8_WAIT_V
#undef PG8_WAIT_L
#undef PG8_BAR
#undef PG8_SCHED
}
}

namespace pg8 {
typedef unsigned u32x4 __attribute__((ext_vector_type(4)));
typedef float f32x2_t __attribute__((ext_vector_type(2))); typedef __bf16 bf16x2_t __attribute__((ext_vector_type(2)));
__device__ __forceinline__ unsigned cvtpk2(float lo, float hi) { f32x2_t v = {lo, hi}; bf16x2_t b = __builtin_convertvector(v, bf16x2_t); return __builtin_bit_cast(unsigned, b); }
__device__ __forceinline__ u32x4 pack8(f32x4 a, f32x4 b) { u32x4 w; w.x = cvtpk2(a[0], a[1]); w.y = cvtpk2(a[2], a[3]); w.z = cvtpk2(b[0], b[1]); w.w = cvtpk2(b[2], b[3]); return w; }
__device__ __forceinline__ void rope8(f32x4& v0, f32x4& v1, const f32x4 c4, const f32x4 s4) {
    const f32x4 a = (f32x4){v0[0], v0[2], v1[0], v1[2]}, b = (f32x4){v0[1], v0[3], v1[1], v1[3]};
    const f32x4 x = a * c4 - b * s4, y = b * c4 + a * s4;
    v0 = (f32x4){x[0], y[0], x[1], y[1]}; v1 = (f32x4){x[2], y[2], x[3], y[3]}; }
__device__ __forceinline__ float sq8(const f32x4 a, const f32x4 b) { return (a[0] * a[0] + a[1] * a[1]) + (a[2] * a[2] + a[3] * a[3]) + (b[0] * b[0] + b[1] * b[1]) + (b[2] * b[2] + b[3] * b[3]); }
#define EPI_FENCE() asm volatile("" ::: "memory")
__device__ __forceinline__ void load_rs(float (&rs)[2][4], const float* ssq, int row0, float inv_kd) {
    float t[2][4];
#pragma unroll
    for (int ai = 0; ai < 2; ++ai)
#pragma unroll
        for (int m = 0; m < 4; ++m) t[ai][m] = ssq[row0 + ai * HALF + m * 16];
#pragma unroll
    for (int ai = 0; ai < 2; ++ai)
#pragma unroll
        for (int m = 0; m < 4; ++m) rs[ai][m] = rsqrtf(t[ai][m] * inv_kd + 1e-6f);
}

struct EpiQKV {
    static constexpr bool PERM = true, AFTER_DRAIN = false;
    bf16_t* O; const float* ssq; const float* cs; const float* sn; float qscale;
    __device__ __forceinline__ void operator()(const f32x4 (&acc)[2][2][4][2], const Unit& u, int wr, int wc, int fr, int fq) const {
        const int row0 = u.pm * BM + wr * 64 + fr, colt = u.pn * BM, region = colt >> 10;
        const int col0 = colt + wc * 32 + 8 * fq, j0 = (wc & 1) * 16 + 4 * fq;
        float rs[2][4]; load_rs(rs, ssq, row0, 1.0f / 1024.0f);
        const float qs = region == 0 ? qscale : 1.f;
#pragma unroll
        for (int ai = 0; ai < 2; ++ai) {
            f32x4 c4[4], s4[4];
            if (region < 2) {
#pragma unroll
                for (int m = 0; m < 4; ++m) { const int pos = (row0 + ai * HALF + m * 16) & 4095; c4[m] = *(const f32x4*)(cs + pos * 32 + j0); s4[m] = *(const f32x4*)(sn + pos * 32 + j0); }
            }
#pragma unroll
            for (int m = 0; m < 4; ++m) {
                const int row = row0 + ai * HALF + m * 16; const float r = rs[ai][m] * qs;
                bf16_t* rowp = O + (size_t)row * 3072 + col0;
#pragma unroll
                for (int bj = 0; bj < 2; ++bj) { f32x4 v0 = acc[ai][bj][m][0] * r, v1 = acc[ai][bj][m][1] * r;
                    if (region < 2) rope8(v0, v1, c4[m], s4[m]);
                    *(u32x4*)(rowp + bj * HALF) = pack8(v0, v1); }
            }
            EPI_FENCE();
        }
    }
};
struct EpiRes {
    static constexpr bool PERM = true, AFTER_DRAIN = false;
    bf16_t* hb; float* ssq;
    __device__ __forceinline__ void operator()(const f32x4 (&acc)[2][2][4][2], const Unit& u, int wr, int wc, int fr, int fq) const {
        const int row0 = u.pm * BM + wr * 64 + fr, col0 = u.pn * BM + wc * 32 + 8 * fq;
#pragma unroll
        for (int ai = 0; ai < 2; ++ai) {
            u32x4 bw[4][2];
#pragma unroll
            for (int m = 0; m < 4; ++m)
#pragma unroll
                for (int bj = 0; bj < 2; ++bj) bw[m][bj] = *(const u32x4*)(hb + (size_t)(row0 + ai * HALF + m * 16) * 1024 + col0 + bj * HALF);
#pragma unroll
            for (int m = 0; m < 4; ++m) {
                const int row = row0 + ai * HALF + m * 16; const size_t off = (size_t)row * 1024 + col0; float s = 0.f;
#pragma unroll
                for (int bj = 0; bj < 2; ++bj) { const u32x4 w = bw[m][bj];
                    const f32x4 b0 = (f32x4){__uint_as_float(w.x << 16), __uint_as_float(w.x & 0xffff0000u), __uint_as_float(w.y << 16), __uint_as_float(w.y & 0xffff0000u)};
                    const f32x4 b1 = (f32x4){__uint_as_float(w.z << 16), __uint_as_float(w.z & 0xffff0000u), __uint_as_float(w.w << 16), __uint_as_float(w.w & 0xffff0000u)};
                    const f32x4 v0 = acc[ai][bj][m][0] + b0, v1 = acc[ai][bj][m][1] + b1;
                    *(u32x4*)(hb + off + bj * HALF) = pack8(v0, v1);
                    s += sq8(v0, v1); }
                s += __shfl_xor(s, 16); s += __shfl_xor(s, 32);
                if (fq == 0) atomicAdd(ssq + row, s);
            }
            EPI_FENCE();
        }
    }
};
struct EpiUp {
    static constexpr bool PERM = true, AFTER_DRAIN = false;
    bf16_t* O; const float* ssq;
    __device__ __forceinline__ void operator()(const f32x4 (&acc)[2][2][4][2], const Unit& u, int wr, int wc, int fr, int fq) const {
        const int row0 = u.pm * BM + wr * 64 + fr, col0 = u.pn * BM + wc * 32 + 8 * fq;
        float rs[2][4]; load_rs(rs, ssq, row0, 1.0f / 1024.0f);
#pragma unroll
        for (int ai = 0; ai < 2; ++ai)
#pragma unroll
            for (int m = 0; m < 4; ++m) {
                const int row = row0 + ai * HALF + m * 16; const float r = rs[ai][m];
                bf16_t* rowp = O + (size_t)row * 4096 + col0;
#pragma unroll
                for (int bj = 0; bj < 2; ++bj) { f32x4 v0 = acc[ai][bj][m][0] * r, v1 = acc[ai][bj][m][1] * r;
#pragma unroll
                    for (int e = 0; e < 4; ++e) { const float a = fmaxf(v0[e], 0.f), b = fmaxf(v1[e], 0.f); v0[e] = a * a; v1[e] = b * b; }
                    *(u32x4*)(rowp + bj * HALF) = pack8(v0, v1); }
            }
    }
};
struct EpiDkvq {
    static constexpr bool PERM = true, AFTER_DRAIN = false;
    bf16_t* Cb; bf16_t* KR; bf16_t* CQ; const float* ssq; float* ssq_c; float* ssq_q; const float* cs; const float* sn;
    __device__ __forceinline__ void operator()(const f32x4 (&acc)[2][2][4][2], const Unit& u, int wr, int wc, int fr, int fq) const {
        const int row0 = u.pm * BM + wr * 64 + fr;
        float rs[2][4]; load_rs(rs, ssq, row0, 1.0f / 1024.0f);
#pragma unroll
        for (int bj = 0; bj < 2; ++bj) {
            const int g = u.pn * BM + bj * HALF + wc * 32;
            if (g >= 704) continue;
            const bool isrope = (g >= 256 && g < 320);
#pragma unroll
            for (int ai = 0; ai < 2; ++ai) {
                f32x4 c4[4], s4[4];
                if (isrope) { const int j0 = ((g - 256) >> 1) + 4 * fq;
#pragma unroll
                    for (int m = 0; m < 4; ++m) { const int pos = (row0 + ai * HALF + m * 16) & 4095; c4[m] = *(const f32x4*)(cs + pos * 32 + j0); s4[m] = *(const f32x4*)(sn + pos * 32 + j0); } }
#pragma unroll
                for (int m = 0; m < 4; ++m) {
                    const int row = row0 + ai * HALF + m * 16; const float r = rs[ai][m];
                    f32x4 v0 = acc[ai][bj][m][0] * r, v1 = acc[ai][bj][m][1] * r;
                    if (g < 256) {
                        *(u32x4*)(Cb + (size_t)row * 256 + g + 8 * fq) = pack8(v0, v1);
                        float s = sq8(v0, v1); s += __shfl_xor(s, 16); s += __shfl_xor(s, 32); if (fq == 0) atomicAdd(ssq_c + row, s);
                    } else if (isrope) {
                        rope8(v0, v1, c4[m], s4[m]);
                        *(u32x4*)(KR + (size_t)row * 64 + (g - 256) + 8 * fq) = pack8(v0, v1);
                    } else {
                        *(u32x4*)(CQ + (size_t)row * 384 + (g - 320) + 8 * fq) = pack8(v0, v1);
                        float s = sq8(v0, v1); s += __shfl_xor(s, 16); s += __shfl_xor(s, 32); if (fq == 0) atomicAdd(ssq_q + row, s);
                    }
                }
                EPI_FENCE();
            }
        }
    }
};
template <bool ROPE192, int LDC> struct EpiLat {
    static constexpr bool PERM = true, AFTER_DRAIN = false;
    bf16_t* O; const float* ssq; float inv_kd; float scale; const float* cs; const float* sn;
    __device__ __forceinline__ void operator()(const f32x4 (&acc)[2][2][4][2], const Unit& u, int wr, int wc, int fr, int fq) const {
        const int row0 = u.pm * BM + wr * 64 + fr;
        float rs[2][4]; load_rs(rs, ssq, row0, inv_kd);
#pragma unroll
        for (int bj = 0; bj < 2; ++bj) {
            const int g = u.pn * BM + bj * HALF + wc * 32; const int hc = g % 192; const bool isrope = ROPE192 && hc >= 128;
#pragma unroll
            for (int ai = 0; ai < 2; ++ai) {
                f32x4 c4[4], s4[4];
                if (isrope) { const int j0 = ((hc - 128) >> 1) + 4 * fq;
#pragma unroll
                    for (int m = 0; m < 4; ++m) { const int pos = (row0 + ai * HALF + m * 16) & 4095; c4[m] = *(const f32x4*)(cs + pos * 32 + j0); s4[m] = *(const f32x4*)(sn + pos * 32 + j0); } }
#pragma unroll
                for (int m = 0; m < 4; ++m) {
                    const int row = row0 + ai * HALF + m * 16; const float r = rs[ai][m] * scale;
                    f32x4 v0 = acc[ai][bj][m][0] * r, v1 = acc[ai][bj][m][1] * r;
                    if (isrope) rope8(v0, v1, c4[m], s4[m]);
                    *(u32x4*)(O + (size_t)row * LDC + g + 8 * fq) = pack8(v0, v1);
                }
                EPI_FENCE();
            }
        }
    }
};
#undef EPI_FENCE
}
namespace att {
typedef unsigned short bf16_t;
typedef short bf16x8 __attribute__((ext_vector_type(8)));
typedef short s16x4 __attribute__((ext_vector_type(4)));
typedef float f32x16 __attribute__((ext_vector_type(16)));
typedef float f32x4 __attribute__((ext_vector_type(4)));
typedef unsigned u32x4 __attribute__((ext_vector_type(4)));
#define SBAR() __builtin_amdgcn_sched_barrier(0)
constexpr int SHM_V = 16384;
constexpr float THR = 8.f;
__device__ __forceinline__ int v_st(int k, int c) { const int kk = (k & ~0xC) | ((k & 4) << 1) | ((k & 8) >> 1); return ((kk >> 3) * 4 + (c >> 5)) * 512 + ((kk & 7) * 32 + (c & 31)) * 2; }
__device__ __forceinline__ int v_rd_base(int lane) { return ((lane & 3) << 3) | (((lane >> 2) & 3) << 6) | (((lane >> 4) & 1) << 5) | (((lane >> 5) & 1) << 8); }
__device__ __forceinline__ int crow(int r, int hi) { return (r & 3) + 8 * (r >> 2) + 4 * hi; }
typedef float f32x2_t __attribute__((ext_vector_type(2))); typedef __bf16 bf16x2_t __attribute__((ext_vector_type(2)));
__device__ __forceinline__ unsigned cvtpk(float lo, float hi) { f32x2_t v = {lo, hi}; bf16x2_t b = __builtin_convertvector(v, bf16x2_t); return __builtin_bit_cast(unsigned, b); }
template <int ROWB> __device__ __forceinline__ int kswz(int row, int colB) { return row * ROWB + (colB ^ ((row & (ROWB == 256 ? 15 : 7)) << 4)); }

__device__ __forceinline__ void mask_tile(f32x16& p0, f32x16& p1, int dq) {
    const float NEG = -__builtin_inff();
#pragma unroll
    for (int r = 0; r < 16; ++r) { const int c = (r & 3) + 8 * (r >> 2); if (dq - c < 0) p0[r] = NEG; if (dq - c - 32 < 0) p1[r] = NEG; }
}
template <int NQ, int ROWB>
__device__ __forceinline__ void qkt(f32x16& p0, f32x16& p1, const char* Kt, int cofs, int r32, int hi, const bf16x8* qr) {
    constexpr int GS = (NQ > 4) ? 2 : 4, NG = NQ / GS;
    const char* kb[4];
#pragma unroll
    for (int dd = 0; dd < 4; ++dd) kb[dd] = Kt + kswz<ROWB>(r32, cofs + (dd * 16 + hi * 8) * 2);
    bf16x8 kf[2][2 * GS];
#define KLD(g, bufi) do { _Pragma("unroll") for (int e = 0; e < GS; ++e) { const int d0_ = (g) * GS + e; const char* a_ = kb[d0_ & 3] + (d0_ >> 2) * 128; \
        kf[bufi][2 * e] = *reinterpret_cast<const bf16x8*>(a_); kf[bufi][2 * e + 1] = *reinterpret_cast<const bf16x8*>(a_ + 32 * ROWB); } } while (0)
    KLD(0, 0);
#pragma unroll
    for (int g = 0; g < NG; ++g) {
        if (g + 1 < NG) KLD(g + 1, (g + 1) & 1);
        SBAR();
#pragma unroll
        for (int e = 0; e < GS; ++e) {
            if (g == 0 && e == 0) { p0 = __builtin_amdgcn_mfma_f32_32x32x16_bf16(kf[0][0], qr[0], f32x16{}, 0, 0, 0); p1 = __builtin_amdgcn_mfma_f32_32x32x16_bf16(kf[0][1], qr[0], f32x16{}, 0, 0, 0); }
            else { p0 = __builtin_amdgcn_mfma_f32_32x32x16_bf16(kf[g & 1][2 * e], qr[g * GS + e], p0, 0, 0, 0); p1 = __builtin_amdgcn_mfma_f32_32x32x16_bf16(kf[g & 1][2 * e + 1], qr[g * GS + e], p1, 0, 0, 0); }
        }
        SBAR();
    }
#undef KLD
}
__device__ __forceinline__ void pv_tile(f32x16* o, int vb, bf16x8 pa0, bf16x8 pa1, bf16x8 pa2, bf16x8 pa3) {
#define TRRD(dst, off) asm volatile("ds_read_b64_tr_b16 %0, %1 offset:%2" : "=&v"(dst) : "v"(vb), "i"(off) : "memory")
#define PV_RD(X, d0) do { constexpr int b_ = (d0) * 512; \
        TRRD(X##l0, b_); TRRD(X##h0, b_ + 2048); TRRD(X##l1, b_ + 4096); TRRD(X##h1, b_ + 6144); TRRD(X##l2, b_ + 8192); TRRD(X##h2, b_ + 10240); TRRD(X##l3, b_ + 12288); TRRD(X##h3, b_ + 14336); } while (0)
#define PV_MM(X, d0) do { \
        o[d0] = __builtin_amdgcn_mfma_f32_32x32x16_bf16(pa0, (bf16x8){X##l0[0], X##l0[1], X##l0[2], X##l0[3], X##h0[0], X##h0[1], X##h0[2], X##h0[3]}, o[d0], 0, 0, 0); \
        o[d0] = __builtin_amdgcn_mfma_f32_32x32x16_bf16(pa1, (bf16x8){X##l1[0], X##l1[1], X##l1[2], X##l1[3], X##h1[0], X##h1[1], X##h1[2], X##h1[3]}, o[d0], 0, 0, 0); \
        o[d0] = __builtin_amdgcn_mfma_f32_32x32x16_bf16(pa2, (bf16x8){X##l2[0], X##l2[1], X##l2[2], X##l2[3], X##h2[0], X##h2[1], X##h2[2], X##h2[3]}, o[d0], 0, 0, 0); \
        o[d0] = __builtin_amdgcn_mfma_f32_32x32x16_bf16(pa3, (bf16x8){X##l3[0], X##l3[1], X##l3[2], X##l3[3], X##h3[0], X##h3[1], X##h3[2], X##h3[3]}, o[d0], 0, 0, 0); } while (0)
    s16x4 al0, al1, al2, al3, ah0, ah1, ah2, ah3, bl0, bl1, bl2, bl3, bh0, bh1, bh2, bh3;
    PV_RD(a, 0); PV_RD(b, 1);
    asm volatile("s_waitcnt lgkmcnt(8)" ::: "memory"); SBAR(); PV_MM(a, 0); SBAR();
    PV_RD(a, 2);
    asm volatile("s_waitcnt lgkmcnt(8)" ::: "memory"); SBAR(); PV_MM(b, 1); SBAR();
    PV_RD(b, 3);
    asm volatile("s_waitcnt lgkmcnt(8)" ::: "memory"); SBAR(); PV_MM(a, 2); SBAR();
    asm volatile("s_waitcnt lgkmcnt(0)" ::: "memory"); SBAR(); PV_MM(b, 3);
#undef PV_RD
#undef PV_MM
#undef TRRD
}
__device__ __forceinline__ void softmax_tile(f32x16& p0, f32x16& p1, float& m_reg, float& l_reg, f32x16* o, float* al_l, int r32, int hi,
                                             bf16x8& pa0, bf16x8& pa1, bf16x8& pa2, bf16x8& pa3) {
    float pmax = p0[0];
#pragma unroll
    for (int r = 1; r < 16; ++r) pmax = fmaxf(pmax, p0[r]);
#pragma unroll
    for (int r = 0; r < 16; ++r) pmax = fmaxf(pmax, p1[r]);
    { auto rr = __builtin_amdgcn_permlane32_swap(__float_as_uint(pmax), __float_as_uint(pmax), false, false);
      pmax = fmaxf(__uint_as_float(rr[0]), __uint_as_float(rr[1])); }
    if (!__all(pmax - m_reg <= THR)) {
        const float mn = fmaxf(m_reg, pmax); const float alpha = __builtin_amdgcn_exp2f(m_reg - mn); m_reg = mn; l_reg *= alpha;
        if (hi == 0) al_l[r32] = alpha;
        asm volatile("s_waitcnt lgkmcnt(0)" ::: "memory");
#pragma unroll
        for (int g = 0; g < 4; ++g) { const f32x4 a4 = *(const f32x4*)(al_l + 8 * g + 4 * hi);
#pragma unroll
            for (int d = 0; d < 4; ++d)
#pragma unroll
                for (int e = 0; e < 4; ++e) o[d][4 * g + e] *= a4[e]; }
    }
    float ps = 0.f;
#pragma unroll
    for (int r = 0; r < 16; ++r) { p0[r] = __builtin_amdgcn_exp2f(p0[r] - m_reg); ps += p0[r]; }
#pragma unroll
    for (int r = 0; r < 16; ++r) { p1[r] = __builtin_amdgcn_exp2f(p1[r] - m_reg); ps += p1[r]; }
    l_reg += ps;
#define PK4(P, B_, OUT) do { u32x4 w = {cvtpk(P[B_+0], P[B_+1]), cvtpk(P[B_+2], P[B_+3]), cvtpk(P[B_+4], P[B_+5]), cvtpk(P[B_+6], P[B_+7])}; OUT = *reinterpret_cast<bf16x8*>(&w); } while (0)
    PK4(p0, 0, pa0); PK4(p0, 8, pa1); PK4(p1, 0, pa2); PK4(p1, 8, pa3);
#undef PK4
}

template <int ROWB>
__device__ __forceinline__ void qk_sm_interleaved(f32x16& n0, f32x16& n1, f32x16& c0, f32x16& c1, const char* Kt, int cofs, int r32, int hi, const bf16x8* qr,
                                                  float& m_reg, float& l_reg, f32x16* o, float* al_l, bf16x8& pa0, bf16x8& pa1, bf16x8& pa2, bf16x8& pa3) {
    bf16x8 kf[8];
#pragma unroll
    for (int dd = 0; dd < 4; ++dd) { const char* a_ = Kt + kswz<ROWB>(r32, cofs + (dd * 16 + hi * 8) * 2);
        kf[2 * dd] = *reinterpret_cast<const bf16x8*>(a_); kf[2 * dd + 1] = *reinterpret_cast<const bf16x8*>(a_ + 32 * ROWB); }
    SBAR();
    n0 = __builtin_amdgcn_mfma_f32_32x32x16_bf16(kf[0], qr[0], f32x16{}, 0, 0, 0); n1 = __builtin_amdgcn_mfma_f32_32x32x16_bf16(kf[1], qr[0], f32x16{}, 0, 0, 0);
    SBAR();
    float pmax = c0[0];
#pragma unroll
    for (int r = 1; r < 16; ++r) pmax = fmaxf(pmax, c0[r]);
    SBAR();
    n0 = __builtin_amdgcn_mfma_f32_32x32x16_bf16(kf[2], qr[1], n0, 0, 0, 0); n1 = __builtin_amdgcn_mfma_f32_32x32x16_bf16(kf[3], qr[1], n1, 0, 0, 0);
    SBAR();
#pragma unroll
    for (int r = 0; r < 16; ++r) pmax = fmaxf(pmax, c1[r]);
    { auto rr = __builtin_amdgcn_permlane32_swap(__float_as_uint(pmax), __float_as_uint(pmax), false, false);
      pmax = fmaxf(__uint_as_float(rr[0]), __uint_as_float(rr[1])); }
    if (!__all(pmax - m_reg <= THR)) {
        const float mn = fmaxf(m_reg, pmax); const float alpha = __builtin_amdgcn_exp2f(m_reg - mn); m_reg = mn; l_reg *= alpha;
        if (hi == 0) al_l[r32] = alpha;
        asm volatile("s_waitcnt lgkmcnt(0)" ::: "memory");
#pragma unroll
        for (int g = 0; g < 4; ++g) { const f32x4 a4 = *(const f32x4*)(al_l + 8 * g + 4 * hi);
#pragma unroll
            for (int d = 0; d < 4; ++d)
#pragma unroll
                for (int e = 0; e < 4; ++e) o[d][4 * g + e] *= a4[e]; }
    }
    SBAR();
    n0 = __builtin_amdgcn_mfma_f32_32x32x16_bf16(kf[4], qr[2], n0, 0, 0, 0); n1 = __builtin_amdgcn_mfma_f32_32x32x16_bf16(kf[5], qr[2], n1, 0, 0, 0);
    SBAR();
    float ps = 0.f;
#pragma unroll
    for (int r = 0; r < 16; ++r) { c0[r] = __builtin_amdgcn_exp2f(c0[r] - m_reg); ps += c0[r]; }
    SBAR();
    n0 = __builtin_amdgcn_mfma_f32_32x32x16_bf16(kf[6], qr[3], n0, 0, 0, 0); n1 = __builtin_amdgcn_mfma_f32_32x32x16_bf16(kf[7], qr[3], n1, 0, 0, 0);
    SBAR();
#pragma unroll
    for (int r = 0; r < 16; ++r) { c1[r] = __builtin_amdgcn_exp2f(c1[r] - m_reg); ps += c1[r]; }
    l_reg += ps;
#define PK4(P, B_, OUT) do { u32x4 w = {cvtpk(P[B_+0], P[B_+1]), cvtpk(P[B_+2], P[B_+3]), cvtpk(P[B_+4], P[B_+5]), cvtpk(P[B_+6], P[B_+7])}; OUT = *reinterpret_cast<bf16x8*>(&w); } while (0)
    PK4(c0, 0, pa0); PK4(c0, 8, pa1); PK4(c1, 0, pa2); PK4(c1, 8, pa3);
#undef PK4
}
#define ATT_LAS __attribute__((address_space(3)))
template <int MODE>
__device__ __forceinline__ void attn_unit(char* lds, ATT_LAS unsigned char* lds3, const bf16_t* Qb, const bf16_t* Kb, const bf16_t* KRb, const bf16_t* Vb, bf16_t* Ob, int q0, float lam, const float* subg,
                                          const bf16_t* nQb, const bf16_t* nKb, const bf16_t* nKRb, const bf16_t* nVb, int nq0, bool has_next, bool primed, bf16x8 (&qr)[MODE ? 12 : 4]) {
    constexpr int QP = MODE ? 1536 : 3072, KP = MODE ? 2048 : 3072, VP = KP, OP = 1024, NQ = MODE ? 12 : 4, ROWB = MODE ? 384 : 256, UROWS = MODE ? 256 : 128, SHM_K = 64 * ROWB;
    constexpr int NKS = MODE ? 3 : 2;
    const int tid = threadIdx.x, wid = __builtin_amdgcn_readfirstlane(tid >> 6), lane = tid & 63, r32 = lane & 31, hi = lane >> 5;
    const int comp = MODE ? 0 : (wid & 1), rg = MODE ? wid : (wid >> 1);
    const int qrow0 = q0 + rg * 32;
    const int NT = (q0 + UROWS) / 64;
    char* V_lds = lds; char* K_lds = lds + 2 * SHM_V;
    float* wsf = (float*)(lds + 2 * SHM_V + 2 * SHM_K) + wid * 64; float* li_l = wsf; float* al_l = wsf + 32;
    unsigned koff[NKS]; unsigned krope = 0u; int voff[2];
#pragma unroll
    for (int j = 0; j < NKS; ++j) {
        if (MODE) { const int cidx = 64 * (wid * 3 + j) + lane, row = cidx / 24, pc = cidx - row * 24, lc = (pc & ~7) | ((pc & 7) ^ (row & 7));
            if (lc < 16) { koff[j] = (unsigned)(row * KP + lc * 8); } else { koff[j] = (unsigned)(row * 64 + (lc - 16) * 8); krope |= 1u << j; } }
        else { const int row = 4 * (wid * 2 + j) + (lane >> 4), pc = lane & 15, lc = pc ^ (row & 15); koff[j] = (unsigned)(row * KP + lc * 8); }
    }
#pragma unroll
    for (int j = 0; j < 2; ++j) { const int q = 64 * (wid * 2 + j) + lane, st = q >> 5, w = q & 31, kk = ((st >> 2) << 3) | (w >> 2);
        const int k = kk, c = (st & 3) * 32 + (w & 3) * 8; voff[j] = k * VP + c; }
#define DMA_KX(KB_, KRB_, t, bf) do { _Pragma("unroll") for (int j_ = 0; j_ < NKS; ++j_) { \
        const bool rp_ = MODE && ((krope >> j_) & 1u); const bf16_t* src_ = (rp_ ? (KRB_) + (size_t)(t) * (64 * 64) : (KB_) + (size_t)(t) * (64 * KP)) + koff[j_]; \
        __builtin_amdgcn_global_load_lds((const unsigned*)src_, (ATT_LAS unsigned*)(lds3 + 2 * SHM_V + (bf) * SHM_K + (wid * NKS + j_) * 1024), 16, 0, 0); } } while (0)
#define DMA_VX(VB_, t, bf) do { _Pragma("unroll") for (int j_ = 0; j_ < 2; ++j_) \
        __builtin_amdgcn_global_load_lds((const unsigned*)((VB_) + (size_t)(t) * 64 * VP + voff[j_]), (ATT_LAS unsigned*)(lds3 + (bf) * SHM_V + (wid * 2 + j_) * 1024), 16, 0, 0); } while (0)
#define DMA_K(t, bf) DMA_KX(Kb, KRb, t, bf)
#define DMA_V(t, bf) DMA_VX(Vb, t, bf)
    constexpr bool PIPE = (MODE == 0);
    if (!primed) {
        DMA_K(0, 0); DMA_V(0, 0); if (PIPE) DMA_K(1, 1);
#pragma unroll
        for (int d0 = 0; d0 < NQ; ++d0) qr[d0] = *reinterpret_cast<const bf16x8*>(Qb + (size_t)(qrow0 + r32) * QP + comp * 64 + d0 * 16 + hi * 8);
    }
    const int vb0 = (int)(uintptr_t)V_lds + v_rd_base(lane);
    float m_reg = -1e30f, l_reg = 0.f; f32x16 o[4] = {};
#pragma unroll
    for (int d0 = 0; d0 < NQ; ++d0) asm volatile("" :: "v"(qr[d0]));
    asm volatile("s_waitcnt vmcnt(0)" ::: "memory");
    __syncthreads();
    f32x16 sA0, sA1, sB0, sB1;
    if (PIPE) qkt<NQ, ROWB>(sA0, sA1, K_lds, comp * 128, r32, hi, qr);
    if (PIPE) { asm volatile("s_waitcnt lgkmcnt(0)" ::: "memory"); __syncthreads(); }
#define STEP(C0, C1, N0, N1, t, P) do { \
        const int kb_ = (t) * 64; \
        if (PIPE) { if ((t) + 2 < NT) DMA_K((t) + 2, P); } else { if ((t) + 1 < NT) DMA_K((t) + 1, 1 - (P)); } \
        if ((t) + 1 < NT) DMA_V((t) + 1, 1 - (P)); \
        if (PIPE) { if ((t) + 1 < NT && kb_ + 64 <= qrow0 + 31) qkt<NQ, ROWB>(N0, N1, K_lds + (1 - (P)) * SHM_K, comp * 128, r32, hi, qr); } \
        if (kb_ <= qrow0 + 31) { bf16x8 pa0, pa1, pa2, pa3; \
            if (!PIPE) qkt<NQ, ROWB>(C0, C1, K_lds + (P) * SHM_K, comp * 128, r32, hi, qr); \
            if (kb_ + 63 > qrow0) mask_tile(C0, C1, qrow0 + r32 - kb_ - 4 * hi); \
            softmax_tile(C0, C1, m_reg, l_reg, o, al_l, r32, hi, pa0, pa1, pa2, pa3); \
            SBAR(); \
            pv_tile(o, vb0 + (P) * SHM_V, pa0, pa1, pa2, pa3); } \
        asm volatile("s_waitcnt vmcnt(0)" ::: "memory"); \
        __syncthreads(); } while (0)
#define ISTEP(C0, C1, N0, N1, t, P) do { bf16x8 pa0, pa1, pa2, pa3; \
        DMA_K((t) + 2, P); DMA_V((t) + 1, 1 - (P)); \
        qk_sm_interleaved<ROWB>(N0, N1, C0, C1, K_lds + (1 - (P)) * SHM_K, comp * 128, r32, hi, qr, m_reg, l_reg, o, al_l, pa0, pa1, pa2, pa3); \
        SBAR(); \
        pv_tile(o, vb0 + (P) * SHM_V, pa0, pa1, pa2, pa3); \
        asm volatile("s_waitcnt vmcnt(0)" ::: "memory"); \
        __syncthreads(); } while (0)
    if (PIPE) {
        const int NTI = NT - 2;
#pragma unroll 1
        for (int t = 0; t < NTI; t += 2) { ISTEP(sA0, sA1, sB0, sB1, t, 0); ISTEP(sB0, sB1, sA0, sA1, t + 1, 1); }
        STEP(sA0, sA1, sB0, sB1, NTI, 0); STEP(sB0, sB1, sA0, sA1, NTI + 1, 1);
    } else {
#pragma unroll 1
        for (int t = 0; t < NT; t += 2) { STEP(sA0, sA1, sA0, sA1, t, 0); STEP(sA0, sA1, sA0, sA1, t + 1, 1); }
    }
#undef ISTEP
    if (has_next) {
        DMA_KX(nKb, nKRb, 0, 0); DMA_VX(nVb, 0, 0); if (PIPE) DMA_KX(nKb, nKRb, 1, 1);
        const int nqrow0 = nq0 + rg * 32;
#pragma unroll
        for (int d0 = 0; d0 < NQ; ++d0) qr[d0] = *reinterpret_cast<const bf16x8*>(nQb + (size_t)(nqrow0 + r32) * QP + comp * 64 + d0 * 16 + hi * 8);
    }
#undef STEP
#undef DMA_K
#undef DMA_V
#undef DMA_KX
#undef DMA_VX
    { auto rr = __builtin_amdgcn_permlane32_swap(__float_as_uint(l_reg), __float_as_uint(l_reg), false, false); l_reg = __uint_as_float(rr[0]) + __uint_as_float(rr[1]); }
    if (hi == 0) li_l[r32] = l_reg;
    asm volatile("s_waitcnt lgkmcnt(0)" ::: "memory");
#pragma unroll
    for (int g = 0; g < 4; ++g) { const f32x4 l4 = *(const f32x4*)(li_l + 8 * g + 4 * hi);
#pragma unroll
        for (int e = 0; e < 4; ++e) { const float rl = __builtin_amdgcn_rcpf(l4[e]);
#pragma unroll
            for (int d = 0; d < 4; ++d) o[d][4 * g + e] *= rl; } }
    bf16_t* Ow = Ob + (size_t)qrow0 * OP;
    if (MODE) {
#pragma unroll
        for (int r = 0; r < 16; ++r) { const int orow = crow(r, hi);
#pragma unroll
            for (int d0 = 0; d0 < 4; ++d0) Ow[(size_t)orow * OP + d0 * 32 + r32] = (bf16_t)(cvtpk(o[d0][r], o[d0][r]) & 0xffffu); }
    } else {
        float* xb = (float*)(lds + 2 * SHM_V + 2 * SHM_K + 2048) + rg * 4096;
        if (comp == 1) {
#pragma unroll
            for (int d0 = 0; d0 < 4; ++d0)
#pragma unroll
                for (int r = 0; r < 16; ++r) xb[(d0 * 16 + r) * 64 + lane] = o[d0][r] * lam;
        }
        asm volatile("s_waitcnt lgkmcnt(0)\n\ts_barrier" ::: "memory");
        if (comp == 0) {
            float s[16];
#pragma unroll
            for (int r = 0; r < 16; ++r) { float a = 0.f;
#pragma unroll
                for (int d0 = 0; d0 < 4; ++d0) { const float dv = o[d0][r] - xb[(d0 * 16 + r) * 64 + lane]; o[d0][r] = dv; a += dv * dv; }
                s[r] = a; }
#pragma unroll
            for (int off = 1; off < 32; off <<= 1)
#pragma unroll
                for (int r = 0; r < 16; ++r) s[r] += __shfl_xor(s[r], off);
            float gg[4];
#pragma unroll
            for (int d0 = 0; d0 < 4; ++d0) gg[d0] = subg[d0 * 32 + r32] * 0.8f;
#pragma unroll
            for (int r = 0; r < 16; ++r) { const int orow = crow(r, hi); const float rs = rsqrtf(s[r] * (1.0f / 128.0f) + 1e-5f);
#pragma unroll
                for (int d0 = 0; d0 < 4; ++d0) { const float v = o[d0][r] * rs * gg[d0]; Ow[(size_t)orow * OP + d0 * 32 + r32] = (bf16_t)(cvtpk(v, v) & 0xffffu); } }
        }
    }
}
#undef SBAR
}
#ifndef MK_SINGLE
#define MK_SINGLE 1
#endif
constexpr int NWAVES = 8;
constexpr int BATCH = 8, SEQ = 4096, DM = 1024, M = BATCH * SEQ, FF = 4096;
constexpr int NQKV = 3072, NDKVQ = 768, KVL = 256, QL = 384, NUKV = 2048, NUQ = 1536;
constexpr int NPHASE = 13;
constexpr size_t MiB = 1u << 20;
constexpr size_t WS_WQKV = 2 * MiB, WS_WOA = 8 * MiB, WS_WUP0 = 10 * MiB, WS_WDN0 = 18 * MiB, WS_WDKVQ = 26 * MiB, WS_WUKV = 28 * MiB, WS_WUQ = 29 * MiB,
                 WS_WOB = 31 * MiB, WS_WUP1 = 33 * MiB, WS_WDN1 = 41 * MiB;
constexpr size_t WS_COS = 49 * MiB, WS_SIN = WS_COS + 512 * 1024, WS_SSQ = 50 * MiB;
constexpr size_t WS_HB = 64 * MiB;
constexpr size_t WS_R1 = 128 * MiB;
constexpr size_t WS_KV = WS_R1, WS_QB = WS_R1 + 128 * MiB, WS_CB = WS_R1 + 224 * MiB, WS_KR = WS_R1 + 240 * MiB;
constexpr size_t WS_O = 384 * MiB, WS_CQ = 448 * MiB, WS_END = 472 * MiB;
constexpr int RING_BYTES = 133120, LDS_BYTES = RING_BYTES + 2048;

#define LAS __attribute__((address_space(3)))
typedef unsigned short bf16;
#define RLX_AGENT __ATOMIC_RELAXED, __HIP_MEMORY_SCOPE_AGENT
#define XB_TMO      128
#define XB_XCNT(j)  (256  + 64 * (j))
#define XB_XSUB(j)  (1280 + 64 * (j))
#define XB_XGEN(j)  (2304 + 64 * (j))
#define XB_TOP      3328
#define XB_TOPGEN   3392
#define XCD_BAR_WORDS 3456
#define XB_SPIN_CAP (1u << 18)

__device__ __forceinline__ unsigned xb_ld(unsigned* p)              { return __hip_atomic_load(p, __ATOMIC_RELAXED, __HIP_MEMORY_SCOPE_AGENT); }
__device__ __forceinline__ unsigned xb_add(unsigned* p, unsigned v) { return __hip_atomic_fetch_add(p, v, __ATOMIC_RELAXED, __HIP_MEMORY_SCOPE_AGENT); }
__device__ __forceinline__ unsigned xb_xcc_id() { return (unsigned)__builtin_amdgcn_s_getreg((3 << 11) | 20) & 0xFu; }
#define XB_SPIN(cond, bar) do { unsigned _sp = 0; while (cond) { __builtin_amdgcn_s_sleep(1); \
    if ((++_sp & 255u) == 0u) { if (xb_ld(&(bar)[XB_TMO])) break; if (_sp > XB_SPIN_CAP) { atomicAdd(&(bar)[XB_TMO], 1u); break; } } } } while (0)

struct XcdBarrier {
    unsigned* bar; unsigned x;
    volatile LAS unsigned* st;
};

__device__ __forceinline__ XcdBarrier xcd_barrier_post(unsigned* bar, volatile LAS unsigned* st) {
    XcdBarrier b; b.bar = bar; b.x = xb_xcc_id(); b.st = st;
    if (threadIdx.x == 0) (void)xb_add(&bar[XB_XCNT(b.x)], 1u);
    return b;
}
__device__ __forceinline__ void xcd_barrier_complete(unsigned* bar, unsigned x, unsigned& nloc, unsigned& nx) {
    const unsigned G = gridDim.x * gridDim.y * gridDim.z;
    unsigned sum, cnt, mine, sp = 0u;
    for (;;) {
        sum = 0u; cnt = 0u; mine = 0u;
#pragma unroll
        for (unsigned j = 0; j < 16; ++j) { const unsigned c = xb_ld(&bar[XB_XCNT(j)]); sum += c; cnt += (c > 0u) ? 1u : 0u; mine = (j == x) ? c : mine; }
        if (sum == G) break;
        __builtin_amdgcn_s_sleep(1);
        if ((++sp & 255u) == 0u) { if (xb_ld(&bar[XB_TMO])) break; if (sp > XB_SPIN_CAP) { atomicAdd(&bar[XB_TMO], 1u); break; } }
    }
    nloc = mine > 0u ? mine : 1u; nx = cnt > 0u ? cnt : 1u;
}

__device__ __forceinline__ void xcd_barrier(const XcdBarrier& b) {
    asm volatile("s_waitcnt vmcnt(0)" ::: "memory");
    __syncthreads();
    if (threadIdx.x == 0) {
        unsigned* bar = b.bar;
        __builtin_amdgcn_s_waitcnt(0);
        unsigned nloc = b.st[0], nx = b.st[1];
        if (nloc == 0u) { xcd_barrier_complete(bar, b.x, nloc, nx); b.st[0] = nloc; b.st[1] = nx; }
        const unsigned old = xb_add(&bar[XB_XSUB(b.x)], 1u);
        const unsigned gen = old / nloc;
        if (old + 1u == (gen + 1u) * nloc) {
            __builtin_amdgcn_fence(__ATOMIC_RELEASE, "agent");
            asm volatile("s_waitcnt vmcnt(0)" ::: "memory");
            const unsigned og = xb_add(&bar[XB_TOP], 1u);
            const unsigned tg = og / nx;
            if (og + 1u == (tg + 1u) * nx) xb_add(&bar[XB_TOPGEN], 1u);
            else XB_SPIN(xb_ld(&bar[XB_TOPGEN]) == tg, bar);
            __builtin_amdgcn_fence(__ATOMIC_ACQUIRE, "agent");
            xb_add(&bar[XB_XGEN(b.x)], 1u);
            asm volatile("s_waitcnt vmcnt(0)" ::: "memory");
        } else {
            XB_SPIN(xb_ld(&bar[XB_XGEN(b.x)]) == gen, bar);
            __builtin_amdgcn_fence(__ATOMIC_ACQUIRE, "agent");
            asm volatile("s_waitcnt vmcnt(0)" ::: "memory");
        }
    }
    __syncthreads();
}

constexpr size_t WS_BAR = 1 * MiB;
typedef unsigned v4u __attribute__((ext_vector_type(4)));
typedef float f32x4 __attribute__((ext_vector_type(4)));
__device__ __forceinline__ unsigned pk2(float lo, float hi) { return pg8::cvt_pk_bf16(lo, hi); }
__device__ __forceinline__ float wave_sum(float v) {
#pragma unroll
    for (int o = 1; o < 64; o <<= 1) v += __shfl_xor(v, o);
    return v;
}
__device__ __forceinline__ int src_col(int mode, int n) {
    if (mode == 1) { if (n < 2048) { const int i = n & 63; return (n & ~63) + ((i & 1) << 5) + (i >> 1); } return n; }
    if (mode == 2) { if (n >= 256) { const int i = n - 256; return 256 + ((i & 1) << 5) + (i >> 1); } return n; }
    if (mode == 3) { const int hd = n / 192, i = n - hd * 192; if (i >= 128) { const int j = i - 128; return hd * 192 + 128 + ((j & 1) << 5) + (j >> 1); } return n; }
    return n;
}
__device__ __forceinline__ void conv_item(const float* W, int K, int N, const float* gain, bf16* WT, int row_off, int mode, LAS float* scr, int item, int lane) {
    const int nblk = N / 32, kb = item / nblk, nb = item % nblk, k0 = 64 * kb, n0 = 32 * nb;
    const int sc_ = src_col(mode, n0 + (lane & 31));
#pragma unroll 16
    for (int i = 0; i < 32; ++i) { const int kk = 2 * i + (lane >> 5); float w = W[(size_t)(k0 + kk) * N + sc_]; if (gain) w *= gain[k0 + kk]; scr[kk * 33 + (lane & 31)] = w; }
    asm volatile("s_waitcnt lgkmcnt(0)" ::: "memory");
    const int c = lane & 7;
#pragma unroll
    for (int j = 0; j < 4; ++j) { const int n = (lane >> 3) + 8 * j; const LAS float* s = scr + (8 * c) * 33 + n;
        v4u o; o.x = pk2(s[0 * 33], s[1 * 33]); o.y = pk2(s[2 * 33], s[3 * 33]); o.z = pk2(s[4 * 33], s[5 * 33]); o.w = pk2(s[6 * 33], s[7 * 33]);
        *(v4u*)(WT + (size_t)(row_off + n0 + n) * K + k0 + 8 * c) = o; }
    asm volatile("s_waitcnt lgkmcnt(0)" ::: "memory");
}
__device__ __forceinline__ void conv_matrix(const float* W, int K, int N, const float* gain, bf16* WT, int row_off, int mode, LAS float* scr, int gw, int NGW, int lane) {
    const int nitems = (K / 64) * (N / 32);
    for (int it = gw; it < nitems; it += NGW) conv_item(W, K, N, gain, WT, row_off, mode, scr, it, lane);
}

struct Args { const float* in[21]; float* out; unsigned char* ws; float inv_freq[32]; int ph_lo, ph_hi; };

__global__ void __launch_bounds__(NWAVES * 64, 2) mk_fwd(Args args) {
    extern __shared__ __attribute__((aligned(16))) unsigned char lds[];
    cg::grid_group grid = cg::this_grid();
    const int tid = threadIdx.x, lane = tid & 63, wave = __builtin_amdgcn_readfirstlane(tid >> 6);
    const int G = gridDim.x, bx = blockIdx.x;
    const int vcu = (G % 8 == 0) ? (bx % 8) * (G / 8) + bx / 8 : bx;
    unsigned char* ws = args.ws;
    const float* x = args.in[0]; float* out = args.out;
    bf16* Wqkv = (bf16*)(ws + WS_WQKV); bf16* Woa = (bf16*)(ws + WS_WOA); bf16* Wup0 = (bf16*)(ws + WS_WUP0); bf16* Wdn0 = (bf16*)(ws + WS_WDN0);
    bf16* Wdkvq = (bf16*)(ws + WS_WDKVQ); bf16* Wukv = (bf16*)(ws + WS_WUKV); bf16* Wuq = (bf16*)(ws + WS_WUQ); bf16* Wob = (bf16*)(ws + WS_WOB);
    bf16* Wup1 = (bf16*)(ws + WS_WUP1); bf16* Wdn1 = (bf16*)(ws + WS_WDN1);
    float* COS = (float*)(ws + WS_COS); float* SIN = (float*)(ws + WS_SIN);
    float* SSQ = (float*)(ws + WS_SSQ);
    bf16* HB = (bf16*)(ws + WS_HB); bf16* QKV = (bf16*)(ws + WS_R1); bf16* U = (bf16*)(ws + WS_R1);
    bf16* KVb = (bf16*)(ws + WS_KV); bf16* QB = (bf16*)(ws + WS_QB); bf16* CB = (bf16*)(ws + WS_CB); bf16* KR = (bf16*)(ws + WS_KR);
    bf16* OB = (bf16*)(ws + WS_O); bf16* CQ = (bf16*)(ws + WS_CQ);
    const int lo = args.ph_lo, hi_ = args.ph_hi;
#ifndef PHMASK
#define PHMASK 0x1fff
#endif
#define IN(k) ((((PHMASK) >> (k)) & 1) && lo <= (k) && (k) < hi_)
#ifndef DUPMASK
#define DUPMASK 0
#endif
#define NREP(k) (1 + (((DUPMASK) >> (k)) & 1))
#ifndef SYNCDUP
#define SYNCDUP 1
#endif
#define SEAM(k) do { if (IN(k) && IN((k) + 1)) { for (int s_ = 0; s_ < SYNCDUP; ++s_) { xcd_barrier(bar); } } } while (0)
    LAS unsigned char* lds3 = (LAS unsigned char*)lds;
    volatile LAS unsigned* MISC = (volatile LAS unsigned*)(lds3 + RING_BYTES + 1024);
    if (tid < 2) MISC[tid] = 0u;
    __syncthreads();
    XcdBarrier bar; bar.bar = (unsigned*)(ws + WS_BAR); bar.x = 0; bar.st = MISC;
    if (args.ph_hi - args.ph_lo > 1) bar = xcd_barrier_post((unsigned*)(ws + WS_BAR), MISC);
    if (args.ph_lo > 4096) grid.sync();
    constexpr float LOG2E = 1.4426950408889634f;

    for (int rep0_ = 0; rep0_ < NREP(0); ++rep0_) if (IN(0)) {
        LAS float* scr = (LAS float*)(lds3 + wave * 16384);
        const int gw = vcu * NWAVES + wave, NGW = G * NWAVES;
        {
            constexpr int I0 = (DM / 64) * (NQKV / 32), I1 = I0 + (DM / 64) * (DM / 32), I2 = I1 + (DM / 64) * (FF / 32), I3 = I2 + (FF / 64) * (DM / 32),
                          I4 = I3 + (DM / 64) * (320 / 32), I5 = I4 + (DM / 64) * (QL / 32), I6 = I5 + (KVL / 64) * (NUKV / 32), I7 = I6 + (QL / 64) * (NUQ / 32),
                          I8 = I7 + (DM / 64) * (DM / 32), I9 = I8 + (DM / 64) * (FF / 32), I10 = I9 + (FF / 64) * (DM / 32);
            for (int it = gw; it < I10; it += NGW) {
                if (it < I0) conv_item(args.in[2], DM, NQKV, args.in[1], Wqkv, 0, 1, scr, it, lane);
                else if (it < I1) conv_item(args.in[8], DM, DM, nullptr, Woa, 0, 0, scr, it - I0, lane);
                else if (it < I2) conv_item(args.in[18], DM, FF, args.in[17], Wup0, 0, 0, scr, it - I1, lane);
                else if (it < I3) conv_item(args.in[19], FF, DM, nullptr, Wdn0, 0, 0, scr, it - I2, lane);
                else if (it < I4) conv_item(args.in[10], DM, 320, args.in[9], Wdkvq, 0, 2, scr, it - I3, lane);
                else if (it < I5) conv_item(args.in[13], DM, QL, args.in[1] + DM, Wdkvq, 320, 0, scr, it - I4, lane);
                else if (it < I6) conv_item(args.in[12], KVL, NUKV, args.in[11], Wukv, 0, 0, scr, it - I5, lane);
                else if (it < I7) conv_item(args.in[15], QL, NUQ, args.in[14], Wuq, 0, 3, scr, it - I6, lane);
                else if (it < I8) conv_item(args.in[16], DM, DM, nullptr, Wob, 0, 0, scr, it - I7, lane);
                else if (it < I9) conv_item(args.in[18] + (size_t)DM * FF, DM, FF, args.in[17] + DM, Wup1, 0, 0, scr, it - I8, lane);
                else conv_item(args.in[19] + (size_t)FF * DM, FF, DM, nullptr, Wdn1, 0, 0, scr, it - I9, lane);
            }
        }
        const int gt = bx * (NWAVES * 64) + tid, NGT = G * NWAVES * 64;
        for (int i = gt; i < 64 * DM / 8; i += NGT) ((v4u*)(Wdkvq + (size_t)704 * DM))[i] = (v4u){0u, 0u, 0u, 0u};
        for (int i = gt; i < SEQ * 32; i += NGT) {
            const int pos = i >> 5, j = i & 31; const float ang = (float)pos * args.inv_freq[j];
            double rev = (double)ang * 0.15915494309189535; rev -= floor(rev); const float fr = (float)rev;
            COS[i] = __builtin_amdgcn_cosf(fr); SIN[i] = __builtin_amdgcn_sinf(fr); }
        for (int i = gt; i < 6 * M; i += NGT) SSQ[M + i] = 0.f;
        for (int m = gw; m < M; m += 2 * NGW) {
            const int m2 = m + NGW;
            const bool has2 = m2 < M;
            const f32x4* xr = (const f32x4*)(x + (size_t)m * DM) + lane; const f32x4* xr2 = (const f32x4*)(x + (size_t)(has2 ? m2 : m) * DM) + lane;
            f32x4 v[4], w[4]; float s = 0.f, s2 = 0.f;
#pragma unroll
            for (int j = 0; j < 4; ++j) { v[j] = xr[64 * j]; w[j] = xr2[64 * j]; }
#pragma unroll
            for (int j = 0; j < 4; ++j) { s += (v[j].x * v[j].x + v[j].y * v[j].y) + (v[j].z * v[j].z + v[j].w * v[j].w); s2 += (w[j].x * w[j].x + w[j].y * w[j].y) + (w[j].z * w[j].z + w[j].w * w[j].w); }
            s = wave_sum(s); s2 = wave_sum(s2);
            if (lane == 0) { SSQ[m] = s; if (has2) SSQ[m2] = s2; }
            unsigned long long* o8 = (unsigned long long*)(HB + (size_t)m * DM) + lane; unsigned long long* o82 = (unsigned long long*)(HB + (size_t)(has2 ? m2 : m) * DM) + lane;
#pragma unroll
            for (int j = 0; j < 4; ++j) { o8[64 * j] = (unsigned long long)pk2(v[j].x, v[j].y) | ((unsigned long long)pk2(v[j].z, v[j].w) << 32);
                if (has2) o82[64 * j] = (unsigned long long)pk2(w[j].x, w[j].y) | ((unsigned long long)pk2(w[j].z, w[j].w) << 32); }
        }
    }
    SEAM(0);
    if (IN(1)) {
        pg8::Gemm g{HB, Wqkv, M, NQKV, DM}; pg8::StaticOrder S; S.init(M, NQKV, G, bx); S.rep = NREP(1);
        pg8::EpiQKV E{QKV, SSQ, COS, SIN, 0.125f * LOG2E};
        pg8::gemm_phase<pg8::EpiQKV, pg8::StaticOrder, true, true>(lds3, g, S, E);
    }
    SEAM(1);
    if (IN(2)) {
        const float a1 = wave_sum(args.in[3][lane] * args.in[4][lane]), a2 = wave_sum(args.in[5][lane] * args.in[6][lane]);
        const float lam = __expf(a1) - __expf(a2) + 0.2f;
#ifndef DIFF_SEAM
#define DIFF_SEAM 0
#endif
        att::bf16x8 qrd[4];
        for (int slot = vcu; slot < 256; slot += G) {
            const int xcd = slot >> 5, i = slot & 31; bool primed = false; const int NU = 8 * NREP(2);
            for (int r_ = 0; r_ < NU; ++r_) { const int r = r_ & 7, rn = (r_ + 1) & 7; const bool has_next = r_ + 1 < NU;
                const int bh = 8 * xcd + r, qb = (r & 1) ? i : 31 - i, b = bh >> 3, h = bh & 7;
                const int nbh = 8 * xcd + rn, nqb = (rn & 1) ? i : 31 - i, nb = nbh >> 3, nh = nbh & 7;
                const bf16* base = QKV + (size_t)b * SEQ * NQKV; const bf16* nbase = QKV + (size_t)nb * SEQ * NQKV;
                att::attn_unit<0>((char*)lds, lds3, base + h * 128, base + 1024 + h * 128, nullptr, base + 2048 + h * 128, OB + (size_t)b * SEQ * DM + h * 128, qb * 128, lam, args.in[7],
                                  nbase + nh * 128, nbase + 1024 + nh * 128, nullptr, nbase + 2048 + nh * 128, nqb * 128, DIFF_SEAM && has_next, DIFF_SEAM && primed, qrd);
                primed = has_next;
            }
        }
    }
    SEAM(2);
    if (IN(3)) {
        pg8::Gemm g{OB, Woa, M, DM, DM}; pg8::StaticOrder S; S.init(M, DM, G, bx);
        pg8::EpiRes E{HB, SSQ + M};
        pg8::gemm_phase<pg8::EpiRes, pg8::StaticOrder, true, true>(lds3, g, S, E);
    }
    SEAM(3);
    if (IN(4)) {
        pg8::Gemm g{HB, Wup0, M, FF, DM}; pg8::StaticOrder S; S.init(M, FF, G, bx); S.rep = NREP(4);
        pg8::EpiUp E{U, SSQ + M};
        pg8::gemm_phase<pg8::EpiUp, pg8::StaticOrder, true, true>(lds3, g, S, E);
    }
    SEAM(4);
    if (IN(5)) {
        pg8::Gemm g{U, Wdn0, M, DM, FF}; pg8::StaticOrder S; S.init(M, DM, G, bx);
        pg8::EpiRes E{HB, SSQ + 2 * M};
        pg8::gemm_phase<pg8::EpiRes, pg8::StaticOrder, true, true>(lds3, g, S, E);
    }
    SEAM(5);
    if (IN(6)) {
        pg8::Gemm g{HB, Wdkvq, M, NDKVQ, DM}; pg8::StaticOrder S; S.init(M, NDKVQ, G, bx);
        pg8::EpiDkvq E{CB, KR, CQ, SSQ + 2 * M, SSQ + 5 * M, SSQ + 6 * M, COS, SIN};
        pg8::gemm_phase<pg8::EpiDkvq, pg8::StaticOrder, true, true>(lds3, g, S, E);
    }
    SEAM(6);
    if (IN(7)) {
        { pg8::Gemm g{CB, Wukv, M, NUKV, KVL}; pg8::StaticOrder S; S.init(M, NUKV, G, bx); S.rep = NREP(7);
          pg8::EpiLat<false, NUKV> E{KVb, SSQ + 5 * M, 1.0f / 256.0f, 1.0f, COS, SIN};
          pg8::gemm_phase<pg8::EpiLat<false, NUKV>, pg8::StaticOrder, true, true>(lds3, g, S, E); }
        { pg8::Gemm g{CQ, Wuq, M, NUQ, QL}; pg8::StaticOrder S; S.init(M, NUQ, G, bx); S.rep = NREP(7);
          pg8::EpiLat<true, NUQ> E{QB, SSQ + 6 * M, 1.0f / 384.0f, 0.07216878364870322f * LOG2E, COS, SIN};
          pg8::gemm_phase<pg8::EpiLat<true, NUQ>, pg8::StaticOrder, true, true>(lds3, g, S, E); }
    }
    SEAM(7);
    if (IN(8)) {
        att::bf16x8 qrm[12];
        for (int slot = vcu; slot < 256; slot += G) {
            const int xcd = slot >> 5, i = slot & 31, j = i & 15, gsel = i >> 4; bool primed = false; const int NU = 4 * NREP(8);
            for (int r_ = 0; r_ < NU; ++r_) { const int r = r_ & 3, rn = (r_ + 1) & 3; const bool has_next = r_ + 1 < NU;
                const int bh = 8 * xcd + 4 * (r >> 1) + 2 * gsel + (r & 1), qb = (r & 1) ? j : 15 - j, b = bh >> 3, h = bh & 7;
                const int nbh = 8 * xcd + 4 * (rn >> 1) + 2 * gsel + (rn & 1), nqb = (rn & 1) ? j : 15 - j, nb = nbh >> 3, nh = nbh & 7;
                att::attn_unit<1>((char*)lds, lds3, QB + (size_t)b * SEQ * NUQ + h * 192, KVb + (size_t)b * SEQ * NUKV + h * 256, KR + (size_t)b * SEQ * 64,
                                  KVb + (size_t)b * SEQ * NUKV + h * 256 + 128, OB + (size_t)b * SEQ * DM + h * 128, qb * 256, 0.f, nullptr,
                                  QB + (size_t)nb * SEQ * NUQ + nh * 192, KVb + (size_t)nb * SEQ * NUKV + nh * 256, KR + (size_t)nb * SEQ * 64,
                                  KVb + (size_t)nb * SEQ * NUKV + nh * 256 + 128, nqb * 256, has_next, primed, qrm);
                primed = has_next;
            }
        }
    }
    SEAM(8);
    if (IN(9)) {
        pg8::Gemm g{OB, Wob, M, DM, DM}; pg8::StaticOrder S; S.init(M, DM, G, bx);
        pg8::EpiRes E{HB, SSQ + 3 * M};
        pg8::gemm_phase<pg8::EpiRes, pg8::StaticOrder, true, true>(lds3, g, S, E);
    }
    SEAM(9);
    if (IN(10)) {
        pg8::Gemm g{HB, Wup1, M, FF, DM}; pg8::StaticOrder S; S.init(M, FF, G, bx); S.rep = NREP(10);
        pg8::EpiUp E{U, SSQ + 3 * M};
        pg8::gemm_phase<pg8::EpiUp, pg8::StaticOrder, true, true>(lds3, g, S, E);
    }
    SEAM(10);
    if (IN(11)) {
        pg8::Gemm g{U, Wdn1, M, DM, FF}; pg8::StaticOrder S; S.init(M, DM, G, bx);
        pg8::EpiRes E{HB, SSQ + 4 * M};
        pg8::gemm_phase<pg8::EpiRes, pg8::StaticOrder, true, true>(lds3, g, S, E);
    }
    SEAM(11);
    for (int rep12_ = 0; rep12_ < NREP(12); ++rep12_) if (IN(12)) {
        const int gw = vcu * NWAVES + wave, NGW = G * NWAVES; const float* fg = args.in[20];
        f32x4 gv[4];
#pragma unroll
        for (int j = 0; j < 2; ++j) { gv[2 * j] = ((const f32x4*)fg)[128 * j + 2 * lane]; gv[2 * j + 1] = ((const f32x4*)fg)[128 * j + 2 * lane + 1]; }
        for (int m = gw; m < M; m += NGW) {
            const float rs = rsqrtf(SSQ[4 * M + m] * (1.0f / 1024.0f) + 1e-6f);
            const v4u* hr = (const v4u*)(HB + (size_t)m * DM); f32x4* orow = (f32x4*)(out + (size_t)m * DM);
#pragma unroll
            for (int j = 0; j < 2; ++j) { const v4u w = hr[64 * j + lane];
                const f32x4 a = (f32x4){__uint_as_float(w.x << 16), __uint_as_float(w.x & 0xffff0000u), __uint_as_float(w.y << 16), __uint_as_float(w.y & 0xffff0000u)};
                const f32x4 b = (f32x4){__uint_as_float(w.z << 16), __uint_as_float(w.z & 0xffff0000u), __uint_as_float(w.w << 16), __uint_as_float(w.w & 0xffff0000u)};
                orow[128 * j + 2 * lane] = a * rs * gv[2 * j]; orow[128 * j + 2 * lane + 1] = b * rs * gv[2 * j + 1]; }
        }
    }
#undef IN
#undef SEAM
}

extern "C" void kernel_launch(void* const* d_in, const int* in_sizes, int n_in, void* d_out, int out_size, void* d_ws, size_t ws_size, hipStream_t stream) {
    static int grid = 0;
    if (grid == 0) {
        if (n_in != 21 || in_sizes[0] != M * DM || out_size != M * DM || ws_size < WS_END) {
            fprintf(stderr, "kernel_launch: unexpected shapes (n_in %d, in0 %d, out %d, ws %zu); nothing launched\n", n_in, n_in > 0 ? in_sizes[0] : -1, out_size, ws_size); grid = -1; return; }
        int dev = 0, cus = 0, per_cu = 0;
        (void)hipGetDevice(&dev); (void)hipDeviceGetAttribute(&cus, hipDeviceAttributeMultiprocessorCount, dev);
        if (hipFuncSetAttribute((const void*)mk_fwd, hipFuncAttributeMaxDynamicSharedMemorySize, LDS_BYTES) != hipSuccess) { fprintf(stderr, "kernel_launch: hipFuncSetAttribute failed\n"); grid = -1; return; }
        if (hipOccupancyMaxActiveBlocksPerMultiprocessor(&per_cu, (const void*)mk_fwd, NWAVES * 64, LDS_BYTES) != hipSuccess || per_cu < 1) { fprintf(stderr, "kernel_launch: occupancy query says %d\n", per_cu); per_cu = 1; }
        (void)hipGetLastError();
        if (cus <= 0) cus = 256;
        grid = cus * 1;
    }
    if (grid < 0) return;
    Args a{};
    for (int i = 0; i < 21; ++i) a.in[i] = (const float*)d_in[i];
    a.out = (float*)d_out; a.ws = (unsigned char*)d_ws;
    for (int j = 0; j < 32; ++j) a.inv_freq[j] = powf(10000.0f, -((float)(2 * j)) / 64.0f);
#if MK_SINGLE
    a.ph_lo = 0; a.ph_hi = NPHASE;
    if (hipMemsetAsync((char*)d_ws + WS_BAR, 0, XCD_BAR_WORDS * 4, stream) != hipSuccess) { fprintf(stderr, "kernel_launch: hipMemsetAsync failed\n"); return; }
    void* kargs[] = {&a};
    hipError_t e = hipLaunchCooperativeKernel((const void*)mk_fwd, dim3(grid), dim3(NWAVES * 64), kargs, LDS_BYTES, stream);
    if (e != hipSuccess) fprintf(stderr, "kernel_launch: cooperative launch failed: %s (grid %d)\n", hipGetErrorString(e), grid);
#else
    for (int p = 0; p < NPHASE; ++p) { a.ph_lo = p; a.ph_hi = p + 1; hipLaunchKernelGGL(mk_fwd, dim3(grid), dim3(NWAVES * 64), LDS_BYTES, stream, a); }
#endif
}
```

```cpp
#include <hip/hip_runtime.h>
#include <hip/hip_cooperative_groups.h>
#include <cstdio>
#include <cstdint>
#include <cmath>
namespace cg = cooperative_groups;
#define MK_SINGLE 1
namespace pg8 {
#define PG8_LAS __attribute__((address_space(3)))
typedef unsigned short bf16_t;
typedef short bf16x8 __attribute__((ext_vector_type(8)));
typedef float f32x4 __attribute__((ext_vector_type(4)));
typedef unsigned u32x4 __attribute__((ext_vector_type(4)));
constexpr int BM = 256, BK = 64, HALF = 128, HTB = HALF * BK * 2  , STAGE_BYTES = 8 * HTB, NXCD = 8, WGM = 8;

__host__ __device__ __forceinline__ int lds_byte(int r, int c) { const int st = (r >> 4) * 2 + (c >> 5), rr = r & 15, cc = c & 31, ob = rr * 64 + cc * 2; return st * 1024 + (ob ^ (((ob >> 9) & 1) << 5)); }
__host__ __device__ __forceinline__ void stage_rc(int b, int& R, int& C) { const int st = b / 1024, sb = b % 1024, swz = sb ^ (((sb >> 9) & 1) << 5); R = (st >> 1) * 16 + swz / 64; C = (st & 1) * 32 + (swz % 64) / 2; }
__host__ __device__ __forceinline__ int perm32(int rho) { const int n = rho >> 4, i = rho & 15; return 8 * (i >> 2) + 4 * n + (i & 3); }

struct Unit { int pm, pn; };
struct Gemm { const bf16_t* A; const bf16_t* Bt; int M, N, K; };

struct StaticOrder {
    int nM, nN, nwg, G, c, rep = 1;
    __host__ __device__ void init(int M, int N, int G_, int c_) { nM = M / BM; nN = N / BM; nwg = nM * nN; G = G_; c = c_; }
    __host__ __device__ bool next(int i, Unit& u) const {
        const long L = (long)i * G + c; if (L >= (long)nwg * rep) return false;
        int wgid = (int)(L >= nwg ? L - nwg : L); { const int q = nwg / NXCD, r = nwg % NXCD, xcd = wgid % NXCD, off = wgid / NXCD; wgid = (xcd < r ? xcd * (q + 1) : r * (q + 1) + (xcd - r) * q) + off; }
        const int nig = WGM * nN, gid = wgid / nig, fm = gid * WGM, gsz = (nM - fm) < WGM ? (nM - fm) : WGM;
        u.pm = fm + ((wgid % nig) % gsz); u.pn = (wgid % nig) / gsz; return true;
    }
    __device__ __forceinline__ void a_ready(const Unit&) const {}
    __device__ __forceinline__ void done(const Unit&) const {}
};

__device__ __forceinline__ unsigned cvt_pk_bf16(float lo, float hi) { unsigned r; asm volatile("v_cvt_pk_bf16_f32 %0, %1, %2" : "=v"(r) : "v"(lo), "v"(hi)); return r; }

template <class Epi, class Sched, bool ALIGN_EPI = false, bool SP2 = false>
__device__ __forceinline__ void gemm_phase(PG8_LAS unsigned char* lds, const Gemm g, const Sched& S, const Epi& E) {
    const int tid = threadIdx.x, wid = __builtin_amdgcn_readfirstlane(tid >> 6), lane = tid & 63, wr = wid >> 2, wc = wid & 3, fr = lane & 15, fq = lane >> 4;
    const int K = g.K, nt = K / BK;
    unsigned voffA[2], voffB[2];
#pragma unroll
    for (int i = 0; i < 2; ++i) { int R, C; stage_rc(tid * 16 + i * 8192, R, C); const int Rb = Epi::PERM ? ((R & ~31) + perm32(R & 31)) : R;
        voffA[i] = (unsigned)(R * K + C) * 2u; voffB[i] = (unsigned)(Rb * K + C) * 2u; }
    const size_t kstep = (size_t)(BK * 2);
    const size_t hstep = (size_t)HALF * K * 2;
    const size_t tstep = 2 * hstep;
    const unsigned ldsw = (unsigned)wid * 1024u;
    const int aoff = lds_byte(wr * 64 + fr, fq * 8), boff = lds_byte(wc * 32 + fr, fq * 8);
#define PG8_SA(b, h) (((b) * 2 + (h)) * HTB)
#define PG8_SB(b, h) ((4 + (b) * 2 + (h)) * HTB)
#define PG8_STAGE(bufoff, gbase, voff) do { _Pragma("unroll") for (int _i = 0; _i < 2; ++_i) \
        __builtin_amdgcn_global_load_lds((const unsigned*)((const char*)(gbase) + (voff)[_i]), (PG8_LAS unsigned*)(lds + (bufoff) + ldsw + _i * 8192), 16, 0, 0); } while (0)
#define PG8_LDA(dst, b, h) do { _Pragma("unroll") for (int m = 0; m < 4; ++m) _Pragma("unroll") for (int k = 0; k < 2; ++k) dst[m][k] = *(const PG8_LAS bf16x8*)(lds + PG8_SA(b, h) + aoff + m * 2048 + k * 1024); } while (0)
#define PG8_LDB(dst, b, h) do { _Pragma("unroll") for (int n = 0; n < 2; ++n) _Pragma("unroll") for (int k = 0; k < 2; ++k) dst[n][k] = *(const PG8_LAS bf16x8*)(lds + PG8_SB(b, h) + boff + n * 2048 + k * 1024); } while (0)
#define PG8_MMA(ai, bj, At, Bt) do { __builtin_amdgcn_s_setprio(1); _Pragma("unroll") for (int m = 0; m < 4; ++m) _Pragma("unroll") for (int n = 0; n < 2; ++n) _Pragma("unroll") for (int k = 0; k < 2; ++k) \
        acc[ai][bj][m][n] = __builtin_amdgcn_mfma_f32_16x16x32_bf16(Bt[n][k], At[m][k], acc[ai][bj][m][n], 0, 0, 0); __builtin_amdgcn_s_setprio(0); } while (0)
#define PG8_WAIT_V(n) asm volatile("s_waitcnt vmcnt(" #n ")" ::: "memory")
#define PG8_WAIT_L(n) asm volatile("s_waitcnt lgkmcnt(" #n ")" ::: "memory")
#define PG8_BAR __builtin_amdgcn_s_barrier()
#define PG8_SCHED __builtin_amdgcn_sched_barrier(0)
    Unit cur, nxt; int ui = 0;
    if (!S.next(0, cur)) return;
    f32x4 acc[2][2][4][2];
#pragma unroll
    for (int a = 0; a < 2; ++a)
#pragma unroll
        for (int b = 0; b < 2; ++b)
#pragma unroll
            for (int m = 0; m < 4; ++m)
#pragma unroll
                for (int n = 0; n < 2; ++n) acc[a][b][m][n] = (f32x4){0.f, 0.f, 0.f, 0.f};
    bf16x8 At[4][2], B0[2][2], B1[2][2];
    const char* cA = (const char*)g.A + (size_t)cur.pm * tstep; const char* cB = (const char*)g.Bt + (size_t)cur.pn * tstep;
    S.a_ready(cur);
    if constexpr (SP2) {
        PG8_STAGE(PG8_SB(0, 0), cB, voffB); PG8_STAGE(PG8_SB(0, 1), cB + hstep, voffB); PG8_STAGE(PG8_SA(0, 0), cA, voffA); PG8_STAGE(PG8_SA(0, 1), cA + hstep, voffA);
        if (wr == 1) PG8_BAR;
        PG8_WAIT_V(2); PG8_BAR;
        PG8_STAGE(PG8_SB(1, 0), cB + kstep, voffB); PG8_STAGE(PG8_SA(1, 0), cA + kstep, voffA); PG8_STAGE(PG8_SB(1, 1), cB + hstep + kstep, voffB);
        PG8_WAIT_V(6); PG8_BAR;
    } else {
        PG8_STAGE(PG8_SB(0, 0), cB, voffB); PG8_STAGE(PG8_SA(0, 0), cA, voffA); PG8_STAGE(PG8_SB(0, 1), cB + hstep, voffB); PG8_STAGE(PG8_SA(0, 1), cA + hstep, voffA);
        if (wr == 1) PG8_BAR;
        PG8_WAIT_V(4); PG8_BAR;
        PG8_STAGE(PG8_SB(1, 0), cB + kstep, voffB); PG8_STAGE(PG8_SA(1, 0), cA + kstep, voffA); PG8_STAGE(PG8_SB(1, 1), cB + hstep + kstep, voffB);
        PG8_WAIT_V(6); PG8_BAR;
    }
    for (;;) {
        const bool has_next = S.next(ui + 1, nxt);
        const char* nA = has_next ? (const char*)g.A + (size_t)nxt.pm * tstep : cA; const char* nB = has_next ? (const char*)g.Bt + (size_t)nxt.pn * tstep : cB;
#pragma unroll 1
        for (int t = 0; t < nt; t += 2) {
            const bool last = (t == nt - 2);
            const char* a1 = cA + (size_t)(t + 1) * kstep;
            const char* a2 = last ? nA : cA + (size_t)(t + 2) * kstep; const char* b2 = last ? nB : cB + (size_t)(t + 2) * kstep;
            const char* a3 = a2 + kstep; const char* b3 = b2 + kstep;
            if (last && has_next) S.a_ready(nxt);
            if constexpr (SP2) {
            PG8_LDB(B0, 0, 0); PG8_LDB(B1, 0, 1); PG8_SCHED; PG8_LDA(At, 0, 0); PG8_STAGE(PG8_SA(1, 1), a1 + hstep, voffA);
            PG8_WAIT_V(8); PG8_WAIT_L(0); PG8_BAR; PG8_MMA(0, 0, At, B0); PG8_MMA(0, 1, At, B1); PG8_BAR; PG8_SCHED;
            PG8_LDA(At, 0, 1); PG8_STAGE(PG8_SB(0, 0), b2, voffB); PG8_STAGE(PG8_SB(0, 1), b2 + hstep, voffB); PG8_STAGE(PG8_SA(0, 0), a2, voffA);
            PG8_WAIT_V(8); PG8_WAIT_L(0); PG8_BAR; PG8_MMA(1, 0, At, B0); PG8_MMA(1, 1, At, B1); PG8_BAR; PG8_SCHED;
            PG8_LDB(B0, 1, 0); PG8_LDB(B1, 1, 1); PG8_SCHED; PG8_LDA(At, 1, 0); PG8_STAGE(PG8_SA(0, 1), a2 + hstep, voffA);
            PG8_WAIT_V(8); PG8_WAIT_L(0); PG8_BAR; PG8_MMA(0, 0, At, B0); PG8_MMA(0, 1, At, B1); PG8_BAR; PG8_SCHED;
            PG8_LDA(At, 1, 1); PG8_STAGE(PG8_SB(1, 0), b3, voffB); PG8_STAGE(PG8_SB(1, 1), b3 + hstep, voffB); PG8_STAGE(PG8_SA(1, 0), a3, voffA);
            PG8_WAIT_V(8); PG8_WAIT_L(0); PG8_BAR; PG8_MMA(1, 0, At, B0); PG8_MMA(1, 1, At, B1); PG8_BAR; PG8_SCHED;
            } else {
            PG8_LDB(B0, 0, 0); PG8_SCHED; PG8_LDA(At, 0, 0); PG8_STAGE(PG8_SA(1, 1), a1 + hstep, voffA);
            PG8_WAIT_L(8); PG8_BAR; PG8_WAIT_L(0); PG8_MMA(0, 0, At, B0); PG8_BAR; PG8_SCHED;
            PG8_LDB(B1, 0, 1); PG8_STAGE(PG8_SB(0, 0), b2, voffB);
            PG8_BAR; PG8_WAIT_L(0); PG8_MMA(0, 1, At, B1); PG8_BAR;
            PG8_LDA(At, 0, 1); PG8_STAGE(PG8_SA(0, 0), a2, voffA);
            PG8_BAR; PG8_WAIT_L(0); PG8_MMA(1, 0, At, B0); PG8_BAR; PG8_SCHED;
            PG8_STAGE(PG8_SB(0, 1), b2 + hstep, voffB);
            PG8_WAIT_V(6); PG8_BAR; PG8_MMA(1, 1, At, B1); PG8_BAR;
            PG8_LDB(B0, 1, 0); PG8_SCHED; PG8_LDA(At, 1, 0); PG8_STAGE(PG8_SA(0, 1), a2 + hstep, voffA);
            PG8_WAIT_L(8); PG8_BAR; PG8_WAIT_L(0); PG8_MMA(0, 0, At, B0); PG8_BAR; PG8_SCHED;
            PG8_LDB(B1, 1, 1); PG8_STAGE(PG8_SB(1, 0), b3, voffB);
            PG8_BAR; PG8_WAIT_L(0); PG8_MMA(0, 1, At, B1); PG8_BAR;
            PG8_LDA(At, 1, 1); PG8_STAGE(PG8_SA(1, 0), a3, voffA);
            PG8_BAR; PG8_WAIT_L(0); PG8_MMA(1, 0, At, B0); PG8_BAR; PG8_SCHED;
            PG8_STAGE(PG8_SB(1, 1), b3 + hstep, voffB);
            PG8_WAIT_V(6); PG8_BAR; PG8_MMA(1, 1, At, B1); PG8_BAR;
            }
        }
        if constexpr (ALIGN_EPI) { if (wr == 0) PG8_BAR; }
        if constexpr (!Epi::AFTER_DRAIN) { E(acc, cur, wr, wc, fr, fq); S.done(cur); }
        if (!has_next) break;
#pragma unroll
        for (int a = 0; a < 2; ++a)
#pragma unroll
            for (int b = 0; b < 2; ++b)
#pragma unroll
                for (int m = 0; m < 4; ++m)
#pragma unroll
                    for (int n = 0; n < 2; ++n) acc[a][b][m][n] = (f32x4){0.f, 0.f, 0.f, 0.f};
        cur = nxt; cA = nA; cB = nB; ++ui;
        if constexpr (ALIGN_EPI) { if (wr == 1) PG8_BAR; }
    }
    PG8_WAIT_V(0);
    if constexpr (!ALIGN_EPI) { if (wr == 0) PG8_BAR; }
    PG8_BAR;
    if constexpr (Epi::AFTER_DRAIN) { E.fused(acc, cur, wr, wc, fr, fq, lds, wid, lane); S.done(cur); }
#undef PG8_SA
#undef PG8_SB
#undef PG8_STAGE
#undef PG8_LDA
#undef PG8_LDB
#undef PG8_MMA
#undef PG8_WAIT_V
#undef PG8_WAIT_L
#undef PG8_BAR
#undef PG8_SCHED
}
}

namespace pg8 {
typedef unsigned u32x4 __attribute__((ext_vector_type(4)));
typedef float f32x2_t __attribute__((ext_vector_type(2))); typedef __bf16 bf16x2_t __attribute__((ext_vector_type(2)));
__device__ __forceinline__ unsigned cvtpk2(float lo, float hi) { f32x2_t v = {lo, hi}; bf16x2_t b = __builtin_convertvector(v, bf16x2_t); return __builtin_bit_cast(unsigned, b); }
__device__ __forceinline__ u32x4 pack8(f32x4 a, f32x4 b) { u32x4 w; w.x = cvtpk2(a[0], a[1]); w.y = cvtpk2(a[2], a[3]); w.z = cvtpk2(b[0], b[1]); w.w = cvtpk2(b[2], b[3]); return w; }
__device__ __forceinline__ void rope8(f32x4& v0, f32x4& v1, const f32x4 c4, const f32x4 s4) {
    const f32x4 a = (f32x4){v0[0], v0[2], v1[0], v1[2]}, b = (f32x4){v0[1], v0[3], v1[1], v1[3]};
    const f32x4 x = a * c4 - b * s4, y = b * c4 + a * s4;
    v0 = (f32x4){x[0], y[0], x[1], y[1]}; v1 = (f32x4){x[2], y[2], x[3], y[3]}; }
__device__ __forceinline__ float sq8(const f32x4 a, const f32x4 b) { return (a[0] * a[0] + a[1] * a[1]) + (a[2] * a[2] + a[3] * a[3]) + (b[0] * b[0] + b[1] * b[1]) + (b[2] * b[2] + b[3] * b[3]); }
#define EPI_FENCE() asm volatile("" ::: "memory")
__device__ __forceinline__ void load_rs(float (&rs)[2][4], const float* ssq, int row0, float inv_kd) {
    float t[2][4];
#pragma unroll
    for (int ai = 0; ai < 2; ++ai)
#pragma unroll
        for (int m = 0; m < 4; ++m) t[ai][m] = ssq[row0 + ai * HALF + m * 16];
#pragma unroll
    for (int ai = 0; ai < 2; ++ai)
#pragma unroll
        for (int m = 0; m < 4; ++m) rs[ai][m] = rsqrtf(t[ai][m] * inv_kd + 1e-6f);
}

struct EpiQKV {
    static constexpr bool PERM = true, AFTER_DRAIN = false;
    bf16_t* O; const float* ssq; const float* cs; const float* sn; float qscale;
    __device__ __forceinline__ void operator()(const f32x4 (&acc)[2][2][4][2], const Unit& u, int wr, int wc, int fr, int fq) const {
        const int row0 = u.pm * BM + wr * 64 + fr, colt = u.pn * BM, region = colt >> 10;
        const int col0 = colt + wc * 32 + 8 * fq, j0 = (wc & 1) * 16 + 4 * fq;
        float rs[2][4]; load_rs(rs, ssq, row0, 1.0f / 1024.0f);
        const float qs = region == 0 ? qscale : 1.f;
#pragma unroll
        for (int ai = 0; ai < 2; ++ai) {
            f32x4 c4[4], s4[4];
            if (region < 2) {
#pragma unroll
                for (int m = 0; m < 4; ++m) { const int pos = (row0 + ai * HALF + m * 16) & 4095; c4[m] = *(const f32x4*)(cs + pos * 32 + j0); s4[m] = *(const f32x4*)(sn + pos * 32 + j0); }
            }
#pragma unroll
            for (int m = 0; m < 4; ++m) {
                const int row = row0 + ai * HALF + m * 16; const float r = rs[ai][m] * qs;
                bf16_t* rowp = O + (size_t)row * 3072 + col0;
#pragma unroll
                for (int bj = 0; bj < 2; ++bj) { f32x4 v0 = acc[ai][bj][m][0] * r, v1 = acc[ai][bj][m][1] * r;
                    if (region < 2) rope8(v0, v1, c4[m], s4[m]);
                    *(u32x4*)(rowp + bj * HALF) = pack8(v0, v1); }
            }
            EPI_FENCE();
        }
    }
};
struct EpiRes {
    static constexpr bool PERM = true, AFTER_DRAIN = false;
    bf16_t* hb; float* ssq;
    __device__ __forceinline__ void operator()(const f32x4 (&acc)[2][2][4][2], const Unit& u, int wr, int wc, int fr, int fq) const {
        const int row0 = u.pm * BM + wr * 64 + fr, col0 = u.pn * BM + wc * 32 + 8 * fq;
#pragma unroll
        for (int ai = 0; ai < 2; ++ai) {
            u32x4 bw[4][2];
#pragma unroll
            for (int m = 0; m < 4; ++m)
#pragma unroll
                for (int bj = 0; bj < 2; ++bj) bw[m][bj] = *(const u32x4*)(hb + (size_t)(row0 + ai * HALF + m * 16) * 1024 + col0 + bj * HALF);
#pragma unroll
            for (int m = 0; m < 4; ++m) {
                const int row = row0 + ai * HALF + m * 16; const size_t off = (size_t)row * 1024 + col0; float s = 0.f;
#pragma unroll
                for (int bj = 0; bj < 2; ++bj) { const u32x4 w = bw[m][bj];
                    const f32x4 b0 = (f32x4){__uint_as_float(w.x << 16), __uint_as_float(w.x & 0xffff0000u), __uint_as_float(w.y << 16), __uint_as_float(w.y & 0xffff0000u)};
                    const f32x4 b1 = (f32x4){__uint_as_float(w.z << 16), __uint_as_float(w.z & 0xffff0000u), __uint_as_float(w.w << 16), __uint_as_float(w.w & 0xffff0000u)};
                    const f32x4 v0 = acc[ai][bj][m][0] + b0, v1 = acc[ai][bj][m][1] + b1;
                    *(u32x4*)(hb + off + bj * HALF) = pack8(v0, v1);
                    s += sq8(v0, v1); }
                s += __shfl_xor(s, 16); s += __shfl_xor(s, 32);
                if (fq == 0) atomicAdd(ssq + row, s);
            }
            EPI_FENCE();
        }
    }
};
struct EpiUp {
    static constexpr bool PERM = true, AFTER_DRAIN = false;
    bf16_t* O; const float* ssq;
    __device__ __forceinline__ void operator()(const f32x4 (&acc)[2][2][4][2], const Unit& u, int wr, int wc, int fr, int fq) const {
        const int row0 = u.pm * BM + wr * 64 + fr, col0 = u.pn * BM + wc * 32 + 8 * fq;
        float rs[2][4]; load_rs(rs, ssq, row0, 1.0f / 1024.0f);
#pragma unroll
        for (int ai = 0; ai < 2; ++ai)
#pragma unroll
            for (int m = 0; m < 4; ++m) {
                const int row = row0 + ai * HALF + m * 16; const float r = rs[ai][m];
                bf16_t* rowp = O + (size_t)row * 4096 + col0;
#pragma unroll
                for (int bj = 0; bj < 2; ++bj) { f32x4 v0 = acc[ai][bj][m][0] * r, v1 = acc[ai][bj][m][1] * r;
#pragma unroll
                    for (int e = 0; e < 4; ++e) { const float a = fmaxf(v0[e], 0.f), b = fmaxf(v1[e], 0.f); v0[e] = a * a; v1[e] = b * b; }
                    *(u32x4*)(rowp + bj * HALF) = pack8(v0, v1); }
            }
    }
};
struct EpiDkvq {
    static constexpr bool PERM = true, AFTER_DRAIN = false;
    bf16_t* Cb; bf16_t* KR; bf16_t* CQ; const float* ssq; float* ssq_c; float* ssq_q; const float* cs; const float* sn;
    __device__ __forceinline__ void operator()(const f32x4 (&acc)[2][2][4][2], const Unit& u, int wr, int wc, int fr, int fq) const {
        const int row0 = u.pm * BM + wr * 64 + fr;
        float rs[2][4]; load_rs(rs, ssq, row0, 1.0f / 1024.0f);
#pragma unroll
        for (int bj = 0; bj < 2; ++bj) {
            const int g = u.pn * BM + bj * HALF + wc * 32;
            if (g >= 704) continue;
            const bool isrope = (g >= 256 && g < 320);
#pragma unroll
            for (int ai = 0; ai < 2; ++ai) {
                f32x4 c4[4], s4[4];
                if (isrope) { const int j0 = ((g - 256) >> 1) + 4 * fq;
#pragma unroll
                    for (int m = 0; m < 4; ++m) { const int pos = (row0 + ai * HALF + m * 16) & 4095; c4[m] = *(const f32x4*)(cs + pos * 32 + j0); s4[m] = *(const f32x4*)(sn + pos * 32 + j0); } }
#pragma unroll
                for (int m = 0; m < 4; ++m) {
                    const int row = row0 + ai * HALF + m * 16; const float r = rs[ai][m];
                    f32x4 v0 = acc[ai][bj][m][0] * r, v1 = acc[ai][bj][m][1] * r;
                    if (g < 256) {
                        *(u32x4*)(Cb + (size_t)row * 256 + g + 8 * fq) = pack8(v0, v1);
                        float s = sq8(v0, v1); s += __shfl_xor(s, 16); s += __shfl_xor(s, 32); if (fq == 0) atomicAdd(ssq_c + row, s);
                    } else if (isrope) {
                        rope8(v0, v1, c4[m], s4[m]);
                        *(u32x4*)(KR + (size_t)row * 64 + (g - 256) + 8 * fq) = pack8(v0, v1);
                    } else {
                        *(u32x4*)(CQ + (size_t)row * 384 + (g - 320) + 8 * fq) = pack8(v0, v1);
                        float s = sq8(v0, v1); s += __shfl_xor(s, 16); s += __shfl_xor(s, 32); if (fq == 0) atomicAdd(ssq_q + row, s);
                    }
                }
                EPI_FENCE();
            }
        }
    }
};
template <bool ROPE192, int LDC> struct EpiLat {
    static constexpr bool PERM = true, AFTER_DRAIN = false;
    bf16_t* O; const float* ssq; float inv_kd; float scale; const float* cs; const float* sn;
    __device__ __forceinline__ void operator()(const f32x4 (&acc)[2][2][4][2], const Unit& u, int wr, int wc, int fr, int fq) const {
        const int row0 = u.pm * BM + wr * 64 + fr;
        float rs[2][4]; load_rs(rs, ssq, row0, inv_kd);
#pragma unroll
        for (int bj = 0; bj < 2; ++bj) {
            const int g = u.pn * BM + bj * HALF + wc * 32; const int hc = g % 192; const bool isrope = ROPE192 && hc >= 128;
#pragma unroll
            for (int ai = 0; ai < 2; ++ai) {
                f32x4 c4[4], s4[4];
                if (isrope) { const int j0 = ((hc - 128) >> 1) + 4 * fq;
#pragma unroll
                    for (int m = 0; m < 4; ++m) { const int pos = (row0 + ai * HALF + m * 16) & 4095; c4[m] = *(const f32x4*)(cs + pos * 32 + j0); s4[m] = *(const f32x4*)(sn + pos * 32 + j0); } }
#pragma unroll
                for (int m = 0; m < 4; ++m) {
                    const int row = row0 + ai * HALF + m * 16; const float r = rs[ai][m] * scale;
                    f32x4 v0 = acc[ai][bj][m][0] * r, v1 = acc[ai][bj][m][1] * r;
                    if (isrope) rope8(v0, v1, c4[m], s4[m]);
                    *(u32x4*)(O + (size_t)row * LDC + g + 8 * fq) = pack8(v0, v1);
                }
                EPI_FENCE();
            }
        }
    }
};
#undef EPI_FENCE
}
namespace att {
typedef unsigned short bf16_t;
typedef short bf16x8 __attribute__((ext_vector_type(8)));
typedef short s16x4 __attribute__((ext_vector_type(4)));
typedef float f32x16 __attribute__((ext_vector_type(16)));
typedef float f32x4 __attribute__((ext_vector_type(4)));
typedef unsigned u32x4 __attribute__((ext_vector_type(4)));
#define SBAR() __builtin_amdgcn_sched_barrier(0)
constexpr int SHM_V = 16384;
constexpr float THR = 8.f;
__device__ __forceinline__ int v_st(int k, int c) { const int kk = (k & ~0xC) | ((k & 4) << 1) | ((k & 8) >> 1); return ((kk >> 3) * 4 + (c >> 5)) * 512 + ((kk & 7) * 32 + (c & 31)) * 2; }
__device__ __forceinline__ int v_rd_base(int lane) { return ((lane & 3) << 3) | (((lane >> 2) & 3) << 6) | (((lane >> 4) & 1) << 5) | (((lane >> 5) & 1) << 8); }
__device__ __forceinline__ int crow(int r, int hi) { return (r & 3) + 8 * (r >> 2) + 4 * hi; }
typedef float f32x2_t __attribute__((ext_vector_type(2))); typedef __bf16 bf16x2_t __attribute__((ext_vector_type(2)));
__device__ __forceinline__ unsigned cvtpk(float lo, float hi) { f32x2_t v = {lo, hi}; bf16x2_t b = __builtin_convertvector(v, bf16x2_t); return __builtin_bit_cast(unsigned, b); }
template <int ROWB> __device__ __forceinline__ int kswz(int row, int colB) { return row * ROWB + (colB ^ ((row & (ROWB == 256 ? 15 : 7)) << 4)); }

__device__ __forceinline__ void mask_tile(f32x16& p0, f32x16& p1, int dq) {
    const float NEG = -__builtin_inff();
#pragma unroll
    for (int r = 0; r < 16; ++r) { const int c = (r & 3) + 8 * (r >> 2); if (dq - c < 0) p0[r] = NEG; if (dq - c - 32 < 0) p1[r] = NEG; }
}
template <int NQ, int ROWB>
__device__ __forceinline__ void qkt(f32x16& p0, f32x16& p1, const char* Kt, int cofs, int r32, int hi, const bf16x8* qr) {
    constexpr int GS = (NQ > 4) ? 2 : 4, NG = NQ / GS;
    const char* kb[4];
#pragma unroll
    for (int dd = 0; dd < 4; ++dd) kb[dd] = Kt + kswz<ROWB>(r32, cofs + (dd * 16 + hi * 8) * 2);
    bf16x8 kf[2][2 * GS];
#define KLD(g, bufi) do { _Pragma("unroll") for (int e = 0; e < GS; ++e) { const int d0_ = (g) * GS + e; const char* a_ = kb[d0_ & 3] + (d0_ >> 2) * 128; \
        kf[bufi][2 * e] = *reinterpret_cast<const bf16x8*>(a_); kf[bufi][2 * e + 1] = *reinterpret_cast<const bf16x8*>(a_ + 32 * ROWB); } } while (0)
    KLD(0, 0);
#pragma unroll
    for (int g = 0; g < NG; ++g) {
        if (g + 1 < NG) KLD(g + 1, (g + 1) & 1);
        SBAR();
#pragma unroll
        for (int e = 0; e < GS; ++e) {
            if (g == 0 && e == 0) { p0 = __builtin_amdgcn_mfma_f32_32x32x16_bf16(kf[0][0], qr[0], f32x16{}, 0, 0, 0); p1 = __builtin_amdgcn_mfma_f32_32x32x16_bf16(kf[0][1], qr[0], f32x16{}, 0, 0, 0); }
            else { p0 = __builtin_amdgcn_mfma_f32_32x32x16_bf16(kf[g & 1][2 * e], qr[g * GS + e], p0, 0, 0, 0); p1 = __builtin_amdgcn_mfma_f32_32x32x16_bf16(kf[g & 1][2 * e + 1], qr[g * GS + e], p1, 0, 0, 0); }
        }
        SBAR();
    }
#undef KLD
}
__device__ __forceinline__ void pv_tile(f32x16* o, int vb, bf16x8 pa0, bf16x8 pa1, bf16x8 pa2, bf16x8 pa3) {
#define TRRD(dst, off) asm volatile("ds_read_b64_tr_b16 %0, %1 offset:%2" : "=&v"(dst) : "v"(vb), "i"(off) : "memory")
#define PV_RD(X, d0) do { constexpr int b_ = (d0) * 512; \
        TRRD(X##l0, b_); TRRD(X##h0, b_ + 2048); TRRD(X##l1, b_ + 4096); TRRD(X##h1, b_ + 6144); TRRD(X##l2, b_ + 8192); TRRD(X##h2, b_ + 10240); TRRD(X##l3, b_ + 12288); TRRD(X##h3, b_ + 14336); } while (0)
#define PV_MM(X, d0) do { \
        o[d0] = __builtin_amdgcn_mfma_f32_32x32x16_bf16(pa0, (bf16x8){X##l0[0], X##l0[1], X##l0[2], X##l0[3], X##h0[0], X##h0[1], X##h0[2], X##h0[3]}, o[d0], 0, 0, 0); \
        o[d0] = __builtin_amdgcn_mfma_f32_32x32x16_bf16(pa1, (bf16x8){X##l1[0], X##l1[1], X##l1[2], X##l1[3], X##h1[0], X##h1[1], X##h1[2], X##h1[3]}, o[d0], 0, 0, 0); \
        o[d0] = __builtin_amdgcn_mfma_f32_32x32x16_bf16(pa2, (bf16x8){X##l2[0], X##l2[1], X##l2[2], X##l2[3], X##h2[0], X##h2[1], X##h2[2], X##h2[3]}, o[d0], 0, 0, 0); \
        o[d0] = __builtin_amdgcn_mfma_f32_32x32x16_bf16(pa3, (bf16x8){X##l3[0], X##l3[1], X##l3[2], X##l3[3], X##h3[0], X##h3[1], X##h3[2], X##h3[3]}, o[d0], 0, 0, 0); } while (0)
    s16x4 al0, al1, al2, al3, ah0, ah1, ah2, ah3, bl0, bl1, bl2, bl3, bh0, bh1, bh2, bh3;
    PV_RD(a, 0); PV_RD(b, 1);
    asm volatile("s_waitcnt lgkmcnt(8)" ::: "memory"); SBAR(); PV_MM(a, 0); SBAR();
    PV_RD(a, 2);
    asm volatile("s_waitcnt lgkmcnt(8)" ::: "memory"); SBAR(); PV_MM(b, 1); SBAR();
    PV_RD(b, 3);
    asm volatile("s_waitcnt lgkmcnt(8)" ::: "memory"); SBAR(); PV_MM(a, 2); SBAR();
    asm volatile("s_waitcnt lgkmcnt(0)" ::: "memory"); SBAR(); PV_MM(b, 3);
#undef PV_RD
#undef PV_MM
#undef TRRD
}
__device__ __forceinline__ void softmax_tile(f32x16& p0, f32x16& p1, float& m_reg, float& l_reg, f32x16* o, float* al_l, int r32, int hi,
                                             bf16x8& pa0, bf16x8& pa1, bf16x8& pa2, bf16x8& pa3) {
    float pmax = p0[0];
#pragma unroll
    for (int r = 1; r < 16; ++r) pmax = fmaxf(pmax, p0[r]);
#pragma unroll
    for (int r = 0; r < 16; ++r) pmax = fmaxf(pmax, p1[r]);
    { auto rr = __builtin_amdgcn_permlane32_swap(__float_as_uint(pmax), __float_as_uint(pmax), false, false);
      pmax = fmaxf(__uint_as_float(rr[0]), __uint_as_float(rr[1])); }
    if (!__all(pmax - m_reg <= THR)) {
        const float mn = fmaxf(m_reg, pmax); const float alpha = __builtin_amdgcn_exp2f(m_reg - mn); m_reg = mn; l_reg *= alpha;
        if (hi == 0) al_l[r32] = alpha;
        asm volatile("s_waitcnt lgkmcnt(0)" ::: "memory");
#pragma unroll
        for (int g = 0; g < 4; ++g) { const f32x4 a4 = *(const f32x4*)(al_l + 8 * g + 4 * hi);
#pragma unroll
            for (int d = 0; d < 4; ++d)
#pragma unroll
                for (int e = 0; e < 4; ++e) o[d][4 * g + e] *= a4[e]; }
    }
    float ps = 0.f;
#pragma unroll
    for (int r = 0; r < 16; ++r) { p0[r] = __builtin_amdgcn_exp2f(p0[r] - m_reg); ps += p0[r]; }
#pragma unroll
    for (int r = 0; r < 16; ++r) { p1[r] = __builtin_amdgcn_exp2f(p1[r] - m_reg); ps += p1[r]; }
    l_reg += ps;
#define PK4(P, B_, OUT) do { u32x4 w = {cvtpk(P[B_+0], P[B_+1]), cvtpk(P[B_+2], P[B_+3]), cvtpk(P[B_+4], P[B_+5]), cvtpk(P[B_+6], P[B_+7])}; OUT = *reinterpret_cast<bf16x8*>(&w); } while (0)
    PK4(p0, 0, pa0); PK4(p0, 8, pa1); PK4(p1, 0, pa2); PK4(p1, 8, pa3);
#undef PK4
}

template <int ROWB>
__device__ __forceinline__ void qk_sm_interleaved(f32x16& n0, f32x16& n1, f32x16& c0, f32x16& c1, const char* Kt, int cofs, int r32, int hi, const bf16x8* qr,
                                                  float& m_reg, float& l_reg, f32x16* o, float* al_l, bf16x8& pa0, bf16x8& pa1, bf16x8& pa2, bf16x8& pa3) {
    bf16x8 kf[8];
#pragma unroll
    for (int dd = 0; dd < 4; ++dd) { const char* a_ = Kt + kswz<ROWB>(r32, cofs + (dd * 16 + hi * 8) * 2);
        kf[2 * dd] = *reinterpret_cast<const bf16x8*>(a_); kf[2 * dd + 1] = *reinterpret_cast<const bf16x8*>(a_ + 32 * ROWB); }
    SBAR();
    n0 = __builtin_amdgcn_mfma_f32_32x32x16_bf16(kf[0], qr[0], f32x16{}, 0, 0, 0); n1 = __builtin_amdgcn_mfma_f32_32x32x16_bf16(kf[1], qr[0], f32x16{}, 0, 0, 0);
    SBAR();
    float pmax = c0[0];
#pragma unroll
    for (int r = 1; r < 16; ++r) pmax = fmaxf(pmax, c0[r]);
    SBAR();
    n0 = __builtin_amdgcn_mfma_f32_32x32x16_bf16(kf[2], qr[1], n0, 0, 0, 0); n1 = __builtin_amdgcn_mfma_f32_32x32x16_bf16(kf[3], qr[1], n1, 0, 0, 0);
    SBAR();
#pragma unroll
    for (int r = 0; r < 16; ++r) pmax = fmaxf(pmax, c1[r]);
    { auto rr = __builtin_amdgcn_permlane32_swap(__float_as_uint(pmax), __float_as_uint(pmax), false, false);
      pmax = fmaxf(__uint_as_float(rr[0]), __uint_as_float(rr[1])); }
    if (!__all(pmax - m_reg <= THR)) {
        const float mn = fmaxf(m_reg, pmax); const float alpha = __builtin_amdgcn_exp2f(m_reg - mn); m_reg = mn; l_reg *= alpha;
        if (hi == 0) al_l[r32] = alpha;
        asm volatile("s_waitcnt lgkmcnt(0)" ::: "memory");
#pragma unroll
        for (int g = 0; g < 4; ++g) { const f32x4 a4 = *(const f32x4*)(al_l + 8 * g + 4 * hi);
#pragma unroll
            for (int d = 0; d < 4; ++d)
#pragma unroll
                for (int e = 0; e < 4; ++e) o[d][4 * g + e] *= a4[e]; }
    }
    SBAR();
    n0 = __builtin_amdgcn_mfma_f32_32x32x16_bf16(kf[4], qr[2], n0, 0, 0, 0); n1 = __builtin_amdgcn_mfma_f32_32x32x16_bf16(kf[5], qr[2], n1, 0, 0, 0);
    SBAR();
    float ps = 0.f;
#pragma unroll
    for (int r = 0; r < 16; ++r) { c0[r] = __builtin_amdgcn_exp2f(c0[r] - m_reg); ps += c0[r]; }
    SBAR();
    n0 = __builtin_amdgcn_mfma_f32_32x32x16_bf16(kf[6], qr[3], n0, 0, 0, 0); n1 = __builtin_amdgcn_mfma_f32_32x32x16_bf16(kf[7], qr[3], n1, 0, 0, 0);
    SBAR();
#pragma unroll
    for (int r = 0; r < 16; ++r) { c1[r] = __builtin_amdgcn_exp2f(c1[r] - m_reg); ps += c1[r]; }
    l_reg += ps;
#define PK4(P, B_, OUT) do { u32x4 w = {cvtpk(P[B_+0], P[B_+1]), cvtpk(P[B_+2], P[B_+3]), cvtpk(P[B_+4], P[B_+5]), cvtpk(P[B_+6], P[B_+7])}; OUT = *reinterpret_cast<bf16x8*>(&w); } while (0)
    PK4(c0, 0, pa0); PK4(c0, 8, pa1); PK4(c1, 0, pa2); PK4(c1, 8, pa3);
#undef PK4
}
#define ATT_LAS __attribute__((address_space(3)))
template <int MODE>
__device__ __forceinline__ void attn_unit(char* lds, ATT_LAS unsigned char* lds3, const bf16_t* Qb, const bf16_t* Kb, const bf16_t* KRb, const bf16_t* Vb, bf16_t* Ob, int q0, float lam, const float* subg) {
    constexpr int QP = MODE ? 1536 : 3072, KP = MODE ? 2048 : 3072, VP = KP, OP = 1024, NQ = MODE ? 12 : 4, ROWB = MODE ? 384 : 256, UROWS = MODE ? 256 : 128, SHM_K = 64 * ROWB;
    constexpr int NKS = MODE ? 3 : 2;
    const int tid = threadIdx.x, wid = __builtin_amdgcn_readfirstlane(tid >> 6), lane = tid & 63, r32 = lane & 31, hi = lane >> 5;
    const int comp = MODE ? 0 : (wid & 1), rg = MODE ? wid : (wid >> 1);
    const int qrow0 = q0 + rg * 32;
    const int NT = (q0 + UROWS) / 64;
    char* V_lds = lds; char* K_lds = lds + 2 * SHM_V;
    float* wsf = (float*)(lds + 2 * SHM_V + 2 * SHM_K) + wid * 64; float* li_l = wsf; float* al_l = wsf + 32;
    const bf16_t* ksrc[NKS]; int kstr[NKS]; int voff[2];
#pragma unroll
    for (int j = 0; j < NKS; ++j) {
        if (MODE) { const int cidx = 64 * (wid * 3 + j) + lane, row = cidx / 24, pc = cidx - row * 24, lc = (pc & ~7) | ((pc & 7) ^ (row & 7));
            if (lc < 16) { ksrc[j] = Kb + (size_t)row * KP + lc * 8; kstr[j] = 64 * KP; } else { ksrc[j] = KRb + (size_t)row * 64 + (lc - 16) * 8; kstr[j] = 64 * 64; } }
        else { const int row = 4 * (wid * 2 + j) + (lane >> 4), pc = lane & 15, lc = pc ^ (row & 15); ksrc[j] = Kb + (size_t)row * KP + lc * 8; kstr[j] = 64 * KP; }
    }
#pragma unroll
    for (int j = 0; j < 2; ++j) { const int q = 64 * (wid * 2 + j) + lane, st = q >> 5, w = q & 31, kk = ((st >> 2) << 3) | (w >> 2);
        const int k = kk, c = (st & 3) * 32 + (w & 3) * 8; voff[j] = k * VP + c; }
#define DMA_K(t, bf) do { _Pragma("unroll") for (int j_ = 0; j_ < NKS; ++j_) \
        __builtin_amdgcn_global_load_lds((const unsigned*)(ksrc[j_] + (size_t)(t) * kstr[j_]), (ATT_LAS unsigned*)(lds3 + 2 * SHM_V + (bf) * SHM_K + (wid * NKS + j_) * 1024), 16, 0, 0); } while (0)
#define DMA_V(t, bf) do { _Pragma("unroll") for (int j_ = 0; j_ < 2; ++j_) \
        __builtin_amdgcn_global_load_lds((const unsigned*)(Vb + (size_t)(t) * 64 * VP + voff[j_]), (ATT_LAS unsigned*)(lds3 + (bf) * SHM_V + (wid * 2 + j_) * 1024), 16, 0, 0); } while (0)
    constexpr bool PIPE = (MODE == 0);
    DMA_K(0, 0); DMA_V(0, 0); if (PIPE) DMA_K(1, 1);
    bf16x8 qr[NQ];
#pragma unroll
    for (int d0 = 0; d0 < NQ; ++d0) qr[d0] = *reinterpret_cast<const bf16x8*>(Qb + (size_t)(qrow0 + r32) * QP + comp * 64 + d0 * 16 + hi * 8);
    const int vb0 = (int)(uintptr_t)V_lds + v_rd_base(lane);
    float m_reg = -1e30f, l_reg = 0.f; f32x16 o[4] = {};
#pragma unroll
    for (int d0 = 0; d0 < NQ; ++d0) asm volatile("" :: "v"(qr[d0]));
    asm volatile("s_waitcnt vmcnt(0)" ::: "memory");
    __syncthreads();
    f32x16 sA0, sA1, sB0, sB1;
    if (PIPE) qkt<NQ, ROWB>(sA0, sA1, K_lds, comp * 128, r32, hi, qr);
    if (PIPE) { asm volatile("s_waitcnt lgkmcnt(0)" ::: "memory"); __syncthreads(); }
#define STEP(C0, C1, N0, N1, t, P) do { \
        const int kb_ = (t) * 64; \
        if (PIPE) { if ((t) + 2 < NT) DMA_K((t) + 2, P); } else { if ((t) + 1 < NT) DMA_K((t) + 1, 1 - (P)); } \
        if ((t) + 1 < NT) DMA_V((t) + 1, 1 - (P)); \
        if (PIPE) { if ((t) + 1 < NT && kb_ + 64 <= qrow0 + 31) qkt<NQ, ROWB>(N0, N1, K_lds + (1 - (P)) * SHM_K, comp * 128, r32, hi, qr); } \
        if (kb_ <= qrow0 + 31) { bf16x8 pa0, pa1, pa2, pa3; \
            if (!PIPE) qkt<NQ, ROWB>(C0, C1, K_lds + (P) * SHM_K, comp * 128, r32, hi, qr); \
            if (kb_ + 63 > qrow0) mask_tile(C0, C1, qrow0 + r32 - kb_ - 4 * hi); \
            softmax_tile(C0, C1, m_reg, l_reg, o, al_l, r32, hi, pa0, pa1, pa2, pa3); \
            SBAR(); \
            pv_tile(o, vb0 + (P) * SHM_V, pa0, pa1, pa2, pa3); } \
        asm volatile("s_waitcnt vmcnt(0)" ::: "memory"); \
        __syncthreads(); } while (0)
#define ISTEP(C0, C1, N0, N1, t, P) do { bf16x8 pa0, pa1, pa2, pa3; \
        DMA_K((t) + 2, P); DMA_V((t) + 1, 1 - (P)); \
        qk_sm_interleaved<ROWB>(N0, N1, C0, C1, K_lds + (1 - (P)) * SHM_K, comp * 128, r32, hi, qr, m_reg, l_reg, o, al_l, pa0, pa1, pa2, pa3); \
        SBAR(); \
        pv_tile(o, vb0 + (P) * SHM_V, pa0, pa1, pa2, pa3); \
        asm volatile("s_waitcnt vmcnt(0)" ::: "memory"); \
        __syncthreads(); } while (0)
    if (PIPE) {
        const int NTI = NT - 2;
#pragma unroll 1
        for (int t = 0; t < NTI; t += 2) { ISTEP(sA0, sA1, sB0, sB1, t, 0); ISTEP(sB0, sB1, sA0, sA1, t + 1, 1); }
        STEP(sA0, sA1, sB0, sB1, NTI, 0); STEP(sB0, sB1, sA0, sA1, NTI + 1, 1);
    } else {
#pragma unroll 1
        for (int t = 0; t < NT; t += 2) { STEP(sA0, sA1, sA0, sA1, t, 0); STEP(sA0, sA1, sA0, sA1, t + 1, 1); }
    }
#undef ISTEP
#undef STEP
#undef DMA_K
#undef DMA_V
    { auto rr = __builtin_amdgcn_permlane32_swap(__float_as_uint(l_reg), __float_as_uint(l_reg), false, false); l_reg = __uint_as_float(rr[0]) + __uint_as_float(rr[1]); }
    if (hi == 0) li_l[r32] = l_reg;
    asm volatile("s_waitcnt lgkmcnt(0)" ::: "memory");
#pragma unroll
    for (int g = 0; g < 4; ++g) { const f32x4 l4 = *(const f32x4*)(li_l + 8 * g + 4 * hi);
#pragma unroll
        for (int e = 0; e < 4; ++e) { const float rl = __builtin_amdgcn_rcpf(l4[e]);
#pragma unroll
            for (int d = 0; d < 4; ++d) o[d][4 * g + e] *= rl; } }
    bf16_t* Ow = Ob + (size_t)qrow0 * OP;
    constexpr int STG_ROWB = 272;
    if (MODE) {
        char* stg = lds + 2 * SHM_V + 2 * SHM_K + 2048 + wid * (32 * STG_ROWB);
#pragma unroll
        for (int r = 0; r < 16; ++r) { const int orow = crow(r, hi);
#pragma unroll
            for (int d0 = 0; d0 < 4; ++d0) *(bf16_t*)(stg + orow * STG_ROWB + (d0 * 32 + r32) * 2) = (bf16_t)(cvtpk(o[d0][r], o[d0][r]) & 0xffffu); }
#pragma unroll
        for (int i = 0; i < 8; ++i) { const int row = i * 4 + (lane >> 4), ch = lane & 15;
            const u32x4 v = *(const u32x4*)(stg + row * STG_ROWB + ch * 16); *(u32x4*)(Ow + (size_t)row * OP + ch * 8) = v; }
    } else {
        float* xb = (float*)lds + rg * 4096;
        if (comp == 1) {
#pragma unroll
            for (int d0 = 0; d0 < 4; ++d0)
#pragma unroll
                for (int r = 0; r < 16; ++r) xb[(d0 * 16 + r) * 64 + lane] = o[d0][r] * lam;
        }
        __syncthreads();
        if (comp == 0) {
            float s[16];
#pragma unroll
            for (int r = 0; r < 16; ++r) { float a = 0.f;
#pragma unroll
                for (int d0 = 0; d0 < 4; ++d0) { const float dv = o[d0][r] - xb[(d0 * 16 + r) * 64 + lane]; o[d0][r] = dv; a += dv * dv; }
                s[r] = a; }
#pragma unroll
            for (int off = 1; off < 32; off <<= 1)
#pragma unroll
                for (int r = 0; r < 16; ++r) s[r] += __shfl_xor(s[r], off);
            float gg[4];
#pragma unroll
            for (int d0 = 0; d0 < 4; ++d0) gg[d0] = subg[d0 * 32 + r32] * 0.8f;
            char* stg = (char*)xb;
            asm volatile("s_waitcnt lgkmcnt(0)" ::: "memory");
#pragma unroll
            for (int r = 0; r < 16; ++r) { const int orow = crow(r, hi); const float rs = rsqrtf(s[r] * (1.0f / 128.0f) + 1e-5f);
#pragma unroll
                for (int d0 = 0; d0 < 4; ++d0) { const float v = o[d0][r] * rs * gg[d0]; *(bf16_t*)(stg + orow * STG_ROWB + (d0 * 32 + r32) * 2) = (bf16_t)(cvtpk(v, v) & 0xffffu); } }
#pragma unroll
            for (int i = 0; i < 8; ++i) { const int row = i * 4 + (lane >> 4), ch = lane & 15;
                const u32x4 v = *(const u32x4*)(stg + row * STG_ROWB + ch * 16); *(u32x4*)(Ow + (size_t)row * OP + ch * 8) = v; }
        }
        __syncthreads();
    }
}
#undef SBAR
}
#ifndef MK_SINGLE
#define MK_SINGLE 1
#endif
constexpr int NWAVES = 8;
constexpr int BATCH = 8, SEQ = 4096, DM = 1024, M = BATCH * SEQ, FF = 4096;
constexpr int NQKV = 3072, NDKVQ = 768, KVL = 256, QL = 384, NUKV = 2048, NUQ = 1536;
constexpr int NPHASE = 13;
constexpr size_t MiB = 1u << 20;
constexpr size_t WS_WQKV = 2 * MiB, WS_WOA = 8 * MiB, WS_WUP0 = 10 * MiB, WS_WDN0 = 18 * MiB, WS_WDKVQ = 26 * MiB, WS_WUKV = 28 * MiB, WS_WUQ = 29 * MiB,
                 WS_WOB = 31 * MiB, WS_WUP1 = 33 * MiB, WS_WDN1 = 41 * MiB;
constexpr size_t WS_COS = 49 * MiB, WS_SIN = WS_COS + 512 * 1024, WS_SSQ = 50 * MiB;
constexpr size_t WS_HB = 64 * MiB;
constexpr size_t WS_R1 = 128 * MiB;
constexpr size_t WS_KV = WS_R1, WS_QB = WS_R1 + 128 * MiB, WS_CB = WS_R1 + 224 * MiB, WS_KR = WS_R1 + 240 * MiB;
constexpr size_t WS_O = 384 * MiB, WS_CQ = 448 * MiB, WS_END = 472 * MiB;
constexpr int RING_BYTES = 153600, LDS_BYTES = RING_BYTES + 2048;

#define LAS __attribute__((address_space(3)))
typedef unsigned short bf16;
#define RLX_AGENT __ATOMIC_RELAXED, __HIP_MEMORY_SCOPE_AGENT
#define XB_TMO      128
#define XB_XCNT(j)  (256  + 64 * (j))
#define XB_XSUB(j)  (1280 + 64 * (j))
#define XB_XGEN(j)  (2304 + 64 * (j))
#define XB_TOP      3328
#define XB_TOPGEN   3392
#define XCD_BAR_WORDS 3456
#define XB_SPIN_CAP (1u << 18)

__device__ __forceinline__ unsigned xb_ld(unsigned* p)              { return __hip_atomic_load(p, __ATOMIC_RELAXED, __HIP_MEMORY_SCOPE_AGENT); }
__device__ __forceinline__ unsigned xb_add(unsigned* p, unsigned v) { return __hip_atomic_fetch_add(p, v, __ATOMIC_RELAXED, __HIP_MEMORY_SCOPE_AGENT); }
__device__ __forceinline__ unsigned xb_xcc_id() { return (unsigned)__builtin_amdgcn_s_getreg((3 << 11) | 20) & 0xFu; }
#define XB_SPIN(cond, bar) do { unsigned _sp = 0; while (cond) { __builtin_amdgcn_s_sleep(1); \
    if ((++_sp & 255u) == 0u) { if (xb_ld(&(bar)[XB_TMO])) break; if (_sp > XB_SPIN_CAP) { atomicAdd(&(bar)[XB_TMO], 1u); break; } } } } while (0)

struct XcdBarrier {
    unsigned* bar; unsigned x;
    volatile LAS unsigned* st;
};

__device__ __forceinline__ XcdBarrier xcd_barrier_post(unsigned* bar, volatile LAS unsigned* st) {
    XcdBarrier b; b.bar = bar; b.x = xb_xcc_id(); b.st = st;
    if (threadIdx.x == 0) (void)xb_add(&bar[XB_XCNT(b.x)], 1u);
    return b;
}
__device__ __forceinline__ void xcd_barrier_complete(unsigned* bar, unsigned x, unsigned& nloc, unsigned& nx) {
    const unsigned G = gridDim.x * gridDim.y * gridDim.z;
    unsigned sum, cnt, mine, sp = 0u;
    for (;;) {
        sum = 0u; cnt = 0u; mine = 0u;
#pragma unroll
        for (unsigned j = 0; j < 16; ++j) { const unsigned c = xb_ld(&bar[XB_XCNT(j)]); sum += c; cnt += (c > 0u) ? 1u : 0u; mine = (j == x) ? c : mine; }
        if (sum == G) break;
        __builtin_amdgcn_s_sleep(1);
        if ((++sp & 255u) == 0u) { if (xb_ld(&bar[XB_TMO])) break; if (sp > XB_SPIN_CAP) { atomicAdd(&bar[XB_TMO], 1u); break; } }
    }
    nloc = mine > 0u ? mine : 1u; nx = cnt > 0u ? cnt : 1u;
}

__device__ __forceinline__ void xcd_barrier(const XcdBarrier& b) {
    asm volatile("s_waitcnt vmcnt(0)" ::: "memory");
    __syncthreads();
    if (threadIdx.x == 0) {
        unsigned* bar = b.bar;
        __builtin_amdgcn_s_waitcnt(0);
        unsigned nloc = b.st[0], nx = b.st[1];
        if (nloc == 0u) { xcd_barrier_complete(bar, b.x, nloc, nx); b.st[0] = nloc; b.st[1] = nx; }
        const unsigned old = xb_add(&bar[XB_XSUB(b.x)], 1u);
        const unsigned gen = old / nloc;
        if (old + 1u == (gen + 1u) * nloc) {
            __builtin_amdgcn_fence(__ATOMIC_RELEASE, "agent");
            asm volatile("s_waitcnt vmcnt(0)" ::: "memory");
            const unsigned og = xb_add(&bar[XB_TOP], 1u);
            const unsigned tg = og / nx;
            if (og + 1u == (tg + 1u) * nx) xb_add(&bar[XB_TOPGEN], 1u);
            else XB_SPIN(xb_ld(&bar[XB_TOPGEN]) == tg, bar);
            __builtin_amdgcn_fence(__ATOMIC_ACQUIRE, "agent");
            xb_add(&bar[XB_XGEN(b.x)], 1u);
            asm volatile("s_waitcnt vmcnt(0)" ::: "memory");
        } else {
            XB_SPIN(xb_ld(&bar[XB_XGEN(b.x)]) == gen, bar);
            __builtin_amdgcn_fence(__ATOMIC_ACQUIRE, "agent");
            asm volatile("s_waitcnt vmcnt(0)" ::: "memory");
        }
    }
    __syncthreads();
}

constexpr size_t WS_BAR = 1 * MiB;
typedef unsigned v4u __attribute__((ext_vector_type(4)));
typedef float f32x4 __attribute__((ext_vector_type(4)));
__device__ __forceinline__ unsigned pk2(float lo, float hi) { return pg8::cvt_pk_bf16(lo, hi); }
__device__ __forceinline__ float wave_sum(float v) {
#pragma unroll
    for (int o = 1; o < 64; o <<= 1) v += __shfl_xor(v, o);
    return v;
}
__device__ __forceinline__ int src_col(int mode, int n) {
    if (mode == 1) { if (n < 2048) { const int i = n & 63; return (n & ~63) + ((i & 1) << 5) + (i >> 1); } return n; }
    if (mode == 2) { if (n >= 256) { const int i = n - 256; return 256 + ((i & 1) << 5) + (i >> 1); } return n; }
    if (mode == 3) { const int hd = n / 192, i = n - hd * 192; if (i >= 128) { const int j = i - 128; return hd * 192 + 128 + ((j & 1) << 5) + (j >> 1); } return n; }
    return n;
}
__device__ __forceinline__ void conv_item(const float* W, int K, int N, const float* gain, bf16* WT, int row_off, int mode, LAS float* scr, int item, int lane) {
    const int nblk = N / 32, kb = item / nblk, nb = item % nblk, k0 = 64 * kb, n0 = 32 * nb;
    const int sc_ = src_col(mode, n0 + (lane & 31));
#pragma unroll 16
    for (int i = 0; i < 32; ++i) { const int kk = 2 * i + (lane >> 5); float w = W[(size_t)(k0 + kk) * N + sc_]; if (gain) w *= gain[k0 + kk]; scr[kk * 33 + (lane & 31)] = w; }
    asm volatile("s_waitcnt lgkmcnt(0)" ::: "memory");
    const int c = lane & 7;
#pragma unroll
    for (int j = 0; j < 4; ++j) { const int n = (lane >> 3) + 8 * j; const LAS float* s = scr + (8 * c) * 33 + n;
        v4u o; o.x = pk2(s[0 * 33], s[1 * 33]); o.y = pk2(s[2 * 33], s[3 * 33]); o.z = pk2(s[4 * 33], s[5 * 33]); o.w = pk2(s[6 * 33], s[7 * 33]);
        *(v4u*)(WT + (size_t)(row_off + n0 + n) * K + k0 + 8 * c) = o; }
    asm volatile("s_waitcnt lgkmcnt(0)" ::: "memory");
}
__device__ __forceinline__ void conv_matrix(const float* W, int K, int N, const float* gain, bf16* WT, int row_off, int mode, LAS float* scr, int gw, int NGW, int lane) {
    const int nitems = (K / 64) * (N / 32);
    for (int it = gw; it < nitems; it += NGW) conv_item(W, K, N, gain, WT, row_off, mode, scr, it, lane);
}

struct Args { const float* in[21]; float* out; unsigned char* ws; float inv_freq[32]; int ph_lo, ph_hi; };

__global__ void __launch_bounds__(NWAVES * 64, 2) mk_fwd(Args args) {
    extern __shared__ __attribute__((aligned(16))) unsigned char lds[];
    cg::grid_group grid = cg::this_grid();
    const int tid = threadIdx.x, lane = tid & 63, wave = __builtin_amdgcn_readfirstlane(tid >> 6);
    const int G = gridDim.x, bx = blockIdx.x;
    const int vcu = (G % 8 == 0) ? (bx % 8) * (G / 8) + bx / 8 : bx;
    unsigned char* ws = args.ws;
    const float* x = args.in[0]; float* out = args.out;
    bf16* Wqkv = (bf16*)(ws + WS_WQKV); bf16* Woa = (bf16*)(ws + WS_WOA); bf16* Wup0 = (bf16*)(ws + WS_WUP0); bf16* Wdn0 = (bf16*)(ws + WS_WDN0);
    bf16* Wdkvq = (bf16*)(ws + WS_WDKVQ); bf16* Wukv = (bf16*)(ws + WS_WUKV); bf16* Wuq = (bf16*)(ws + WS_WUQ); bf16* Wob = (bf16*)(ws + WS_WOB);
    bf16* Wup1 = (bf16*)(ws + WS_WUP1); bf16* Wdn1 = (bf16*)(ws + WS_WDN1);
    float* COS = (float*)(ws + WS_COS); float* SIN = (float*)(ws + WS_SIN);
    float* SSQ = (float*)(ws + WS_SSQ);
    bf16* HB = (bf16*)(ws + WS_HB); bf16* QKV = (bf16*)(ws + WS_R1); bf16* U = (bf16*)(ws + WS_R1);
    bf16* KVb = (bf16*)(ws + WS_KV); bf16* QB = (bf16*)(ws + WS_QB); bf16* CB = (bf16*)(ws + WS_CB); bf16* KR = (bf16*)(ws + WS_KR);
    bf16* OB = (bf16*)(ws + WS_O); bf16* CQ = (bf16*)(ws + WS_CQ);
    const int lo = args.ph_lo, hi_ = args.ph_hi;
#ifndef PHMASK
#define PHMASK 0x1fff
#endif
#define IN(k) ((((PHMASK) >> (k)) & 1) && lo <= (k) && (k) < hi_)
#ifndef DUPMASK
#define DUPMASK 0
#endif
#define NREP(k) (1 + (((DUPMASK) >> (k)) & 1))
#ifndef SYNCDUP
#define SYNCDUP 1
#endif
#define SEAM(k) do { if (IN(k) && IN((k) + 1)) { for (int s_ = 0; s_ < SYNCDUP; ++s_) { xcd_barrier(bar); } } } while (0)
    LAS unsigned char* lds3 = (LAS unsigned char*)lds;
    volatile LAS unsigned* MISC = (volatile LAS unsigned*)(lds3 + RING_BYTES + 1024);
    if (tid < 2) MISC[tid] = 0u;
    __syncthreads();
    XcdBarrier bar; bar.bar = (unsigned*)(ws + WS_BAR); bar.x = 0; bar.st = MISC;
    if (args.ph_hi - args.ph_lo > 1) bar = xcd_barrier_post((unsigned*)(ws + WS_BAR), MISC);
    if (args.ph_lo > 4096) grid.sync();
    constexpr float LOG2E = 1.4426950408889634f;

    for (int rep0_ = 0; rep0_ < NREP(0); ++rep0_) if (IN(0)) {
        LAS float* scr = (LAS float*)(lds3 + wave * 16384);
        const int gw = vcu * NWAVES + wave, NGW = G * NWAVES;
        {
            constexpr int I0 = (DM / 64) * (NQKV / 32), I1 = I0 + (DM / 64) * (DM / 32), I2 = I1 + (DM / 64) * (FF / 32), I3 = I2 + (FF / 64) * (DM / 32),
                          I4 = I3 + (DM / 64) * (320 / 32), I5 = I4 + (DM / 64) * (QL / 32), I6 = I5 + (KVL / 64) * (NUKV / 32), I7 = I6 + (QL / 64) * (NUQ / 32),
                          I8 = I7 + (DM / 64) * (DM / 32), I9 = I8 + (DM / 64) * (FF / 32), I10 = I9 + (FF / 64) * (DM / 32);
            for (int it = gw; it < I10; it += NGW) {
                if (it < I0) conv_item(args.in[2], DM, NQKV, args.in[1], Wqkv, 0, 1, scr, it, lane);
                else if (it < I1) conv_item(args.in[8], DM, DM, nullptr, Woa, 0, 0, scr, it - I0, lane);
                else if (it < I2) conv_item(args.in[18], DM, FF, args.in[17], Wup0, 0, 0, scr, it - I1, lane);
                else if (it < I3) conv_item(args.in[19], FF, DM, nullptr, Wdn0, 0, 0, scr, it - I2, lane);
                else if (it < I4) conv_item(args.in[10], DM, 320, args.in[9], Wdkvq, 0, 2, scr, it - I3, lane);
                else if (it < I5) conv_item(args.in[13], DM, QL, args.in[1] + DM, Wdkvq, 320, 0, scr, it - I4, lane);
                else if (it < I6) conv_item(args.in[12], KVL, NUKV, args.in[11], Wukv, 0, 0, scr, it - I5, lane);
                else if (it < I7) conv_item(args.in[15], QL, NUQ, args.in[14], Wuq, 0, 3, scr, it - I6, lane);
                else if (it < I8) conv_item(args.in[16], DM, DM, nullptr, Wob, 0, 0, scr, it - I7, lane);
                else if (it < I9) conv_item(args.in[18] + (size_t)DM * FF, DM, FF, args.in[17] + DM, Wup1, 0, 0, scr, it - I8, lane);
                else conv_item(args.in[19] + (size_t)FF * DM, FF, DM, nullptr, Wdn1, 0, 0, scr, it - I9, lane);
            }
        }
        const int gt = bx * (NWAVES * 64) + tid, NGT = G * NWAVES * 64;
        for (int i = gt; i < 64 * DM / 8; i += NGT) ((v4u*)(Wdkvq + (size_t)704 * DM))[i] = (v4u){0u, 0u, 0u, 0u};
        for (int i = gt; i < SEQ * 32; i += NGT) {
            const int pos = i >> 5, j = i & 31; const float ang = (float)pos * args.inv_freq[j];
            double rev = (double)ang * 0.15915494309189535; rev -= floor(rev); const float fr = (float)rev;
            COS[i] = __builtin_amdgcn_cosf(fr); SIN[i] = __builtin_amdgcn_sinf(fr); }
        for (int i = gt; i < 6 * M; i += NGT) SSQ[M + i] = 0.f;
        for (int m = gw; m < M; m += 2 * NGW) {
            const int m2 = m + NGW;
            const bool has2 = m2 < M;
            const f32x4* xr = (const f32x4*)(x + (size_t)m * DM) + lane; const f32x4* xr2 = (const f32x4*)(x + (size_t)(has2 ? m2 : m) * DM) + lane;
            f32x4 v[4], w[4]; float s = 0.f, s2 = 0.f;
#pragma unroll
            for (int j = 0; j < 4; ++j) { v[j] = xr[64 * j]; w[j] = xr2[64 * j]; }
#pragma unroll
            for (int j = 0; j < 4; ++j) { s += (v[j].x * v[j].x + v[j].y * v[j].y) + (v[j].z * v[j].z + v[j].w * v[j].w); s2 += (w[j].x * w[j].x + w[j].y * w[j].y) + (w[j].z * w[j].z + w[j].w * w[j].w); }
            s = wave_sum(s); s2 = wave_sum(s2);
            if (lane == 0) { SSQ[m] = s; if (has2) SSQ[m2] = s2; }
            unsigned long long* o8 = (unsigned long long*)(HB + (size_t)m * DM) + lane; unsigned long long* o82 = (unsigned long long*)(HB + (size_t)(has2 ? m2 : m) * DM) + lane;
#pragma unroll
            for (int j = 0; j < 4; ++j) { o8[64 * j] = (unsigned long long)pk2(v[j].x, v[j].y) | ((unsigned long long)pk2(v[j].z, v[j].w) << 32);
                if (has2) o82[64 * j] = (unsigned long long)pk2(w[j].x, w[j].y) | ((unsigned long long)pk2(w[j].z, w[j].w) << 32); }
        }
    }
    SEAM(0);
    if (IN(1)) {
        pg8::Gemm g{HB, Wqkv, M, NQKV, DM}; pg8::StaticOrder S; S.init(M, NQKV, G, bx); S.rep = NREP(1);
        pg8::EpiQKV E{QKV, SSQ, COS, SIN, 0.125f * LOG2E};
        pg8::gemm_phase<pg8::EpiQKV, pg8::StaticOrder, true, true>(lds3, g, S, E);
    }
    SEAM(1);
    if (IN(2)) {
        const float a1 = wave_sum(args.in[3][lane] * args.in[4][lane]), a2 = wave_sum(args.in[5][lane] * args.in[6][lane]);
        const float lam = __expf(a1) - __expf(a2) + 0.2f;
        for (int slot = vcu; slot < 256; slot += G) {
            const int xcd = slot >> 5, i = slot & 31;
            for (int r_ = 0; r_ < 8 * NREP(2); ++r_) { const int r = r_ & 7;
                const int bh = 8 * xcd + r, qb = (r & 1) ? i : 31 - i, b = bh >> 3, h = bh & 7;
                const bf16* base = QKV + (size_t)b * SEQ * NQKV;
                att::attn_unit<0>((char*)lds, lds3, base + h * 128, base + 1024 + h * 128, nullptr, base + 2048 + h * 128, OB + (size_t)b * SEQ * DM + h * 128, qb * 128, lam, args.in[7]);
            }
        }
    }
    SEAM(2);
    if (IN(3)) {
        pg8::Gemm g{OB, Woa, M, DM, DM}; pg8::StaticOrder S; S.init(M, DM, G, bx);
        pg8::EpiRes E{HB, SSQ + M};
        pg8::gemm_phase<pg8::EpiRes, pg8::StaticOrder, true, true>(lds3, g, S, E);
    }
    SEAM(3);
    if (IN(4)) {
        pg8::Gemm g{HB, Wup0, M, FF, DM}; pg8::StaticOrder S; S.init(M, FF, G, bx); S.rep = NREP(4);
        pg8::EpiUp E{U, SSQ + M};
        pg8::gemm_phase<pg8::EpiUp, pg8::StaticOrder, true, true>(lds3, g, S, E);
    }
    SEAM(4);
    if (IN(5)) {
        pg8::Gemm g{U, Wdn0, M, DM, FF}; pg8::StaticOrder S; S.init(M, DM, G, bx);
        pg8::EpiRes E{HB, SSQ + 2 * M};
        pg8::gemm_phase<pg8::EpiRes, pg8::StaticOrder, true, true>(lds3, g, S, E);
    }
    SEAM(5);
    if (IN(6)) {
        pg8::Gemm g{HB, Wdkvq, M, NDKVQ, DM}; pg8::StaticOrder S; S.init(M, NDKVQ, G, bx);
        pg8::EpiDkvq E{CB, KR, CQ, SSQ + 2 * M, SSQ + 5 * M, SSQ + 6 * M, COS, SIN};
        pg8::gemm_phase<pg8::EpiDkvq, pg8::StaticOrder, true, true>(lds3, g, S, E);
    }
    SEAM(6);
    if (IN(7)) {
        { pg8::Gemm g{CB, Wukv, M, NUKV, KVL}; pg8::StaticOrder S; S.init(M, NUKV, G, bx); S.rep = NREP(7);
          pg8::EpiLat<false, NUKV> E{KVb, SSQ + 5 * M, 1.0f / 256.0f, 1.0f, COS, SIN};
          pg8::gemm_phase<pg8::EpiLat<false, NUKV>, pg8::StaticOrder, true, true>(lds3, g, S, E); }
        { pg8::Gemm g{CQ, Wuq, M, NUQ, QL}; pg8::StaticOrder S; S.init(M, NUQ, G, bx); S.rep = NREP(7);
          pg8::EpiLat<true, NUQ> E{QB, SSQ + 6 * M, 1.0f / 384.0f, 0.07216878364870322f * LOG2E, COS, SIN};
          pg8::gemm_phase<pg8::EpiLat<true, NUQ>, pg8::StaticOrder, true, true>(lds3, g, S, E); }
    }
    SEAM(7);
    if (IN(8)) {
        for (int slot = vcu; slot < 256; slot += G) {
            const int xcd = slot >> 5, i = slot & 31, j = i & 15, gsel = i >> 4;
            for (int r_ = 0; r_ < 4 * NREP(8); ++r_) { const int r = r_ & 3;
                const int bh = 8 * xcd + 4 * (r >> 1) + 2 * gsel + (r & 1), qb = (r & 1) ? j : 15 - j, b = bh >> 3, h = bh & 7;
                att::attn_unit<1>((char*)lds, lds3, QB + (size_t)b * SEQ * NUQ + h * 192, KVb + (size_t)b * SEQ * NUKV + h * 256, KR + (size_t)b * SEQ * 64,
                                  KVb + (size_t)b * SEQ * NUKV + h * 256 + 128, OB + (size_t)b * SEQ * DM + h * 128, qb * 256, 0.f, nullptr);
            }
        }
    }
    SEAM(8);
    if (IN(9)) {
        pg8::Gemm g{OB, Wob, M, DM, DM}; pg8::StaticOrder S; S.init(M, DM, G, bx);
        pg8::EpiRes E{HB, SSQ + 3 * M};
        pg8::gemm_phase<pg8::EpiRes, pg8::StaticOrder, true, true>(lds3, g, S, E);
    }
    SEAM(9);
    if (IN(10)) {
        pg8::Gemm g{HB, Wup1, M, FF, DM}; pg8::StaticOrder S; S.init(M, FF, G, bx); S.rep = NREP(10);
        pg8::EpiUp E{U, SSQ + 3 * M};
        pg8::gemm_phase<pg8::EpiUp, pg8::StaticOrder, true, true>(lds3, g, S, E);
    }
    SEAM(10);
    if (IN(11)) {
        pg8::Gemm g{U, Wdn1, M, DM, FF}; pg8::StaticOrder S; S.init(M, DM, G, bx);
        pg8::EpiRes E{HB, SSQ + 4 * M};
        pg8::gemm_phase<pg8::EpiRes, pg8::StaticOrder, true, true>(lds3, g, S, E);
    }
    SEAM(11);
    for (int rep12_ = 0; rep12_ < NREP(12); ++rep12_) if (IN(12)) {
        const int gw = vcu * NWAVES + wave, NGW = G * NWAVES; const float* fg = args.in[20];
        f32x4 gv[4];
#pragma unroll
        for (int j = 0; j < 2; ++j) { gv[2 * j] = ((const f32x4*)fg)[128 * j + 2 * lane]; gv[2 * j + 1] = ((const f32x4*)fg)[128 * j + 2 * lane + 1]; }
        for (int m = gw; m < M; m += NGW) {
            const float rs = rsqrtf(SSQ[4 * M + m] * (1.0f / 1024.0f) + 1e-6f);
            const v4u* hr = (const v4u*)(HB + (size_t)m * DM); f32x4* orow = (f32x4*)(out + (size_t)m * DM);
#pragma unroll
            for (int j = 0; j < 2; ++j) { const v4u w = hr[64 * j + lane];
                const f32x4 a = (f32x4){__uint_as_float(w.x << 16), __uint_as_float(w.x & 0xffff0000u), __uint_as_float(w.y << 16), __uint_as_float(w.y & 0xffff0000u)};
                const f32x4 b = (f32x4){__uint_as_float(w.z << 16), __uint_as_float(w.z & 0xffff0000u), __uint_as_float(w.w << 16), __uint_as_float(w.w & 0xffff0000u)};
                orow[128 * j + 2 * lane] = a * rs * gv[2 * j]; orow[128 * j + 2 * lane + 1] = b * rs * gv[2 * j + 1]; }
        }
    }
#undef IN
#undef SEAM
}

extern "C" void kernel_launch(void* const* d_in, const int* in_sizes, int n_in, void* d_out, int out_size, void* d_ws, size_t ws_size, hipStream_t stream) {
    static int grid = 0;
    if (grid == 0) {
        if (n_in != 21 || in_sizes[0] != M * DM || out_size != M * DM || ws_size < WS_END) {
            fprintf(stderr, "kernel_launch: unexpected shapes (n_in %d, in0 %d, out %d, ws %zu); nothing launched\n", n_in, n_in > 0 ? in_sizes[0] : -1, out_size, ws_size); grid = -1; return; }
        int dev = 0, cus = 0, per_cu = 0;
        (void)hipGetDevice(&dev); (void)hipDeviceGetAttribute(&cus, hipDeviceAttributeMultiprocessorCount, dev);
        if (hipFuncSetAttribute((const void*)mk_fwd, hipFuncAttributeMaxDynamicSharedMemorySize, LDS_BYTES) != hipSuccess) { fprintf(stderr, "kernel_launch: hipFuncSetAttribute failed\n"); grid = -1; return; }
        if (hipOccupancyMaxActiveBlocksPerMultiprocessor(&per_cu, (const void*)mk_fwd, NWAVES * 64, LDS_BYTES) != hipSuccess || per_cu < 1) { fprintf(stderr, "kernel_launch: occupancy query says %d\n", per_cu); per_cu = 1; }
        (void)hipGetLastError();
        if (cus <= 0) cus = 256;
        grid = cus * 1;
    }
    if (grid < 0) return;
    Args a{};
    for (int i = 0; i < 21; ++i) a.in[i] = (const float*)d_in[i];
    a.out = (float*)d_out; a.ws = (unsigned char*)d_ws;
    for (int j = 0; j < 32; ++j) a.inv_freq[j] = powf(10000.0f, -((float)(2 * j)) / 64.0f);
#if MK_SINGLE
    a.ph_lo = 0; a.ph_hi = NPHASE;
    if (hipMemsetAsync((char*)d_ws + WS_BAR, 0, XCD_BAR_WORDS * 4, stream) != hipSuccess) { fprintf(stderr, "kernel_launch: hipMemsetAsync failed\n"); return; }
    void* kargs[] = {&a};
    hipError_t e = hipLaunchCooperativeKernel((const void*)mk_fwd, dim3(grid), dim3(NWAVES * 64), kargs, LDS_BYTES, stream);
    if (e != hipSuccess) fprintf(stderr, "kernel_launch: cooperative launch failed: %s (grid %d)\n", hipGetErrorString(e), grid);
#else
    for (int p = 0; p < NPHASE; ++p) { a.ph_lo = p; a.ph_hi = p + 1; hipLaunchKernelGGL(mk_fwd, dim3(grid), dim3(NWAVES * 64), LDS_BYTES, stream, a); }
#endif
}
```

```cpp
#include <hip/hip_runtime.h>
#include <hip/hip_cooperative_groups.h>
#include <cstdio>
#include <cstdint>
#include <cmath>
namespace cg = cooperative_groups;
#define MK_SINGLE 1
namespace pg8 {
#define PG8_LAS __attribute__((address_space(3)))
typedef unsigned short bf16_t;
typedef short bf16x8 __attribute__((ext_vector_type(8)));
typedef float f32x4 __attribute__((ext_vector_type(4)));
typedef unsigned u32x4 __attribute__((ext_vector_type(4)));
constexpr int BM = 256, BK = 64, HALF = 128, HTB = HALF * BK * 2  , STAGE_BYTES = 8 * HTB, NXCD = 8, WGM = 8;

__host__ __device__ __forceinline__ int lds_byte(int r, int c) { const int st = (r >> 4) * 2 + (c >> 5), rr = r & 15, cc = c & 31, ob = rr * 64 + cc * 2; return st * 1024 + (ob ^ (((ob >> 9) & 1) << 5)); }
__host__ __device__ __forceinline__ void stage_rc(int b, int& R, int& C) { const int st = b / 1024, sb = b % 1024, swz = sb ^ (((sb >> 9) & 1) << 5); R = (st >> 1) * 16 + swz / 64; C = (st & 1) * 32 + (swz % 64) / 2; }
__host__ __device__ __forceinline__ int perm32(int rho) { const int n = rho >> 4, i = rho & 15; return 8 * (i >> 2) + 4 * n + (i & 3); }

struct Unit { int pm, pn; };
struct Gemm { const bf16_t* A; const bf16_t* Bt; int M, N, K; };

struct StaticOrder {
    int nM, nN, nwg, G, c, rep = 1;
    __host__ __device__ void init(int M, int N, int G_, int c_) { nM = M / BM; nN = N / BM; nwg = nM * nN; G = G_; c = c_; }
    __host__ __device__ bool next(int i, Unit& u) const {
        const long L = (long)i * G + c; if (L >= (long)nwg * rep) return false;
        int wgid = (int)(L >= nwg ? L - nwg : L); { const int q = nwg / NXCD, r = nwg % NXCD, xcd = wgid % NXCD, off = wgid / NXCD; wgid = (xcd < r ? xcd * (q + 1) : r * (q + 1) + (xcd - r) * q) + off; }
        const int nig = WGM * nN, gid = wgid / nig, fm = gid * WGM, gsz = (nM - fm) < WGM ? (nM - fm) : WGM;
        u.pm = fm + ((wgid % nig) % gsz); u.pn = (wgid % nig) / gsz; return true;
    }
    __device__ __forceinline__ void a_ready(const Unit&) const {}
    __device__ __forceinline__ void done(const Unit&) const {}
};

__device__ __forceinline__ unsigned cvt_pk_bf16(float lo, float hi) { unsigned r; asm volatile("v_cvt_pk_bf16_f32 %0, %1, %2" : "=v"(r) : "v"(lo), "v"(hi)); return r; }

template <class Epi, class Sched, bool ALIGN_EPI = false, bool SP2 = false>
__device__ __forceinline__ void gemm_phase(PG8_LAS unsigned char* lds, const Gemm g, const Sched& S, const Epi& E) {
    const int tid = threadIdx.x, wid = __builtin_amdgcn_readfirstlane(tid >> 6), lane = tid & 63, wr = wid >> 2, wc = wid & 3, fr = lane & 15, fq = lane >> 4;
    const int K = g.K, nt = K / BK;
    unsigned voffA[2], voffB[2];
#pragma unroll
    for (int i = 0; i < 2; ++i) { int R, C; stage_rc(tid * 16 + i * 8192, R, C); const int Rb = Epi::PERM ? ((R & ~31) + perm32(R & 31)) : R;
        voffA[i] = (unsigned)(R * K + C) * 2u; voffB[i] = (unsigned)(Rb * K + C) * 2u; }
    const size_t kstep = (size_t)(BK * 2);
    const size_t hstep = (size_t)HALF * K * 2;
    const size_t tstep = 2 * hstep;
    const unsigned ldsw = (unsigned)wid * 1024u;
    const int aoff = lds_byte(wr * 64 + fr, fq * 8), boff = lds_byte(wc * 32 + fr, fq * 8);
#define PG8_SA(b, h) (((b) * 2 + (h)) * HTB)
#define PG8_SB(b, h) ((4 + (b) * 2 + (h)) * HTB)
#define PG8_STAGE(bufoff, gbase, voff) do { _Pragma("unroll") for (int _i = 0; _i < 2; ++_i) \
        __builtin_amdgcn_global_load_lds((const unsigned*)((const char*)(gbase) + (voff)[_i]), (PG8_LAS unsigned*)(lds + (bufoff) + ldsw + _i * 8192), 16, 0, 0); } while (0)
#define PG8_LDA(dst, b, h) do { _Pragma("unroll") for (int m = 0; m < 4; ++m) _Pragma("unroll") for (int k = 0; k < 2; ++k) dst[m][k] = *(const PG8_LAS bf16x8*)(lds + PG8_SA(b, h) + aoff + m * 2048 + k * 1024); } while (0)
#define PG8_LDB(dst, b, h) do { _Pragma("unroll") for (int n = 0; n < 2; ++n) _Pragma("unroll") for (int k = 0; k < 2; ++k) dst[n][k] = *(const PG8_LAS bf16x8*)(lds + PG8_SB(b, h) + boff + n * 2048 + k * 1024); } while (0)
#define PG8_MMA(ai, bj, At, Bt) do { __builtin_amdgcn_s_setprio(1); _Pragma("unroll") for (int m = 0; m < 4; ++m) _Pragma("unroll") for (int n = 0; n < 2; ++n) _Pragma("unroll") for (int k = 0; k < 2; ++k) \
        acc[ai][bj][m][n] = __builtin_amdgcn_mfma_f32_16x16x32_bf16(Bt[n][k], At[m][k], acc[ai][bj][m][n], 0, 0, 0); __builtin_amdgcn_s_setprio(0); } while (0)
#define PG8_WAIT_V(n) asm volatile("s_waitcnt vmcnt(" #n ")" ::: "memory")
#define PG8_WAIT_L(n) asm volatile("s_waitcnt lgkmcnt(" #n ")" ::: "memory")
#define PG8_BAR __builtin_amdgcn_s_barrier()
#define PG8_SCHED __builtin_amdgcn_sched_barrier(0)
    Unit cur, nxt; int ui = 0;
    if (!S.next(0, cur)) return;
    f32x4 acc[2][2][4][2];
#pragma unroll
    for (int a = 0; a < 2; ++a)
#pragma unroll
        for (int b = 0; b < 2; ++b)
#pragma unroll
            for (int m = 0; m < 4; ++m)
#pragma unroll
                for (int n = 0; n < 2; ++n) acc[a][b][m][n] = (f32x4){0.f, 0.f, 0.f, 0.f};
    bf16x8 At[4][2], B0[2][2], B1[2][2];
    const char* cA = (const char*)g.A + (size_t)cur.pm * tstep; const char* cB = (const char*)g.Bt + (size_t)cur.pn * tstep;
    S.a_ready(cur);
    if constexpr (SP2) {
        PG8_STAGE(PG8_SB(0, 0), cB, voffB); PG8_STAGE(PG8_SB(0, 1), cB + hstep, voffB); PG8_STAGE(PG8_SA(0, 0), cA, voffA); PG8_STAGE(PG8_SA(0, 1), cA + hstep, voffA);
        if (wr == 1) PG8_BAR;
        PG8_WAIT_V(2); PG8_BAR;
        PG8_STAGE(PG8_SB(1, 0), cB + kstep, voffB); PG8_STAGE(PG8_SA(1, 0), cA + kstep, voffA); PG8_STAGE(PG8_SB(1, 1), cB + hstep + kstep, voffB);
        PG8_WAIT_V(6); PG8_BAR;
    } else {
        PG8_STAGE(PG8_SB(0, 0), cB, voffB); PG8_STAGE(PG8_SA(0, 0), cA, voffA); PG8_STAGE(PG8_SB(0, 1), cB + hstep, voffB); PG8_STAGE(PG8_SA(0, 1), cA + hstep, voffA);
        if (wr == 1) PG8_BAR;
        PG8_WAIT_V(4); PG8_BAR;
        PG8_STAGE(PG8_SB(1, 0), cB + kstep, voffB); PG8_STAGE(PG8_SA(1, 0), cA + kstep, voffA); PG8_STAGE(PG8_SB(1, 1), cB + hstep + kstep, voffB);
        PG8_WAIT_V(6); PG8_BAR;
    }
    for (;;) {
        const bool has_next = S.next(ui + 1, nxt);
        const char* nA = has_next ? (const char*)g.A + (size_t)nxt.pm * tstep : cA; const char* nB = has_next ? (const char*)g.Bt + (size_t)nxt.pn * tstep : cB;
#pragma unroll 1
        for (int t = 0; t < nt; t += 2) {
            const bool last = (t == nt - 2);
            const char* a1 = cA + (size_t)(t + 1) * kstep;
            const char* a2 = last ? nA : cA + (size_t)(t + 2) * kstep; const char* b2 = last ? nB : cB + (size_t)(t + 2) * kstep;
            const char* a3 = a2 + kstep; const char* b3 = b2 + kstep;
            if (last && has_next) S.a_ready(nxt);
            if constexpr (SP2) {
            PG8_LDB(B0, 0, 0); PG8_LDB(B1, 0, 1); PG8_SCHED; PG8_LDA(At, 0, 0); PG8_STAGE(PG8_SA(1, 1), a1 + hstep, voffA);
            PG8_WAIT_V(8); PG8_WAIT_L(0); PG8_BAR; PG8_MMA(0, 0, At, B0); PG8_MMA(0, 1, At, B1); PG8_BAR; PG8_SCHED;
            PG8_LDA(At, 0, 1); PG8_STAGE(PG8_SB(0, 0), b2, voffB); PG8_STAGE(PG8_SB(0, 1), b2 + hstep, voffB); PG8_STAGE(PG8_SA(0, 0), a2, voffA);
            PG8_WAIT_V(8); PG8_WAIT_L(0); PG8_BAR; PG8_MMA(1, 0, At, B0); PG8_MMA(1, 1, At, B1); PG8_BAR; PG8_SCHED;
            PG8_LDB(B0, 1, 0); PG8_LDB(B1, 1, 1); PG8_SCHED; PG8_LDA(At, 1, 0); PG8_STAGE(PG8_SA(0, 1), a2 + hstep, voffA);
            PG8_WAIT_V(8); PG8_WAIT_L(0); PG8_BAR; PG8_MMA(0, 0, At, B0); PG8_MMA(0, 1, At, B1); PG8_BAR; PG8_SCHED;
            PG8_LDA(At, 1, 1); PG8_STAGE(PG8_SB(1, 0), b3, voffB); PG8_STAGE(PG8_SB(1, 1), b3 + hstep, voffB); PG8_STAGE(PG8_SA(1, 0), a3, voffA);
            PG8_WAIT_V(8); PG8_WAIT_L(0); PG8_BAR; PG8_MMA(1, 0, At, B0); PG8_MMA(1, 1, At, B1); PG8_BAR; PG8_SCHED;
            } else {
            PG8_LDB(B0, 0, 0); PG8_SCHED; PG8_LDA(At, 0, 0); PG8_STAGE(PG8_SA(1, 1), a1 + hstep, voffA);
            PG8_WAIT_L(8); PG8_BAR; PG8_WAIT_L(0); PG8_MMA(0, 0, At, B0); PG8_BAR; PG8_SCHED;
            PG8_LDB(B1, 0, 1); PG8_STAGE(PG8_SB(0, 0), b2, voffB);
            PG8_BAR; PG8_WAIT_L(0); PG8_MMA(0, 1, At, B1); PG8_BAR;
            PG8_LDA(At, 0, 1); PG8_STAGE(PG8_SA(0, 0), a2, voffA);
            PG8_BAR; PG8_WAIT_L(0); PG8_MMA(1, 0, At, B0); PG8_BAR; PG8_SCHED;
            PG8_STAGE(PG8_SB(0, 1), b2 + hstep, voffB);
            PG8_WAIT_V(6); PG8_BAR; PG8_MMA(1, 1, At, B1); PG8_BAR;
            PG8_LDB(B0, 1, 0); PG8_SCHED; PG8_LDA(At, 1, 0); PG8_STAGE(PG8_SA(0, 1), a2 + hstep, voffA);
            PG8_WAIT_L(8); PG8_BAR; PG8_WAIT_L(0); PG8_MMA(0, 0, At, B0); PG8_BAR; PG8_SCHED;
            PG8_LDB(B1, 1, 1); PG8_STAGE(PG8_SB(1, 0), b3, voffB);
            PG8_BAR; PG8_WAIT_L(0); PG8_MMA(0, 1, At, B1); PG8_BAR;
            PG8_LDA(At, 1, 1); PG8_STAGE(PG8_SA(1, 0), a3, voffA);
            PG8_BAR; PG8_WAIT_L(0); PG8_MMA(1, 0, At, B0); PG8_BAR; PG8_SCHED;
            PG8_STAGE(PG8_SB(1, 1), b3 + hstep, voffB);
            PG8_WAIT_V(6); PG8_BAR; PG8_MMA(1, 1, At, B1); PG8_BAR;
            }
        }
        if constexpr (ALIGN_EPI) { if (wr == 0) PG8_BAR; }
        if constexpr (!Epi::AFTER_DRAIN) { E(acc, cur, wr, wc, fr, fq); S.done(cur); }
        if (!has_next) break;
#pragma unroll
        for (int a = 0; a < 2; ++a)
#pragma unroll
            for (int b = 0; b < 2; ++b)
#pragma unroll
                for (int m = 0; m < 4; ++m)
#pragma unroll
                    for (int n = 0; n < 2; ++n) acc[a][b][m][n] = (f32x4){0.f, 0.f, 0.f, 0.f};
        cur = nxt; cA = nA; cB = nB; ++ui;
        if constexpr (ALIGN_EPI) { if (wr == 1) PG8_BAR; }
    }
    PG8_WAIT_V(0);
    if constexpr (!ALIGN_EPI) { if (wr == 0) PG8_BAR; }
    PG8_BAR;
    if constexpr (Epi::AFTER_DRAIN) { E.fused(acc, cur, wr, wc, fr, fq, lds, wid, lane); S.done(cur); }
#undef PG8_SA
#undef PG8_SB
#undef PG8_STAGE
#undef PG8_LDA
#undef PG8_LDB
#undef PG8_MMA
#undef PG8_WAIT_V
#undef PG8_WAIT_L
#undef PG8_BAR
#undef PG8_SCHED
}
}

namespace pg8 {
typedef unsigned u32x4 __attribute__((ext_vector_type(4)));
typedef float f32x2_t __attribute__((ext_vector_type(2))); typedef __bf16 bf16x2_t __attribute__((ext_vector_type(2)));
__device__ __forceinline__ unsigned cvtpk2(float lo, float hi) { f32x2_t v = {lo, hi}; bf16x2_t b = __builtin_convertvector(v, bf16x2_t); return __builtin_bit_cast(unsigned, b); }
__device__ __forceinline__ u32x4 pack8(f32x4 a, f32x4 b) { u32x4 w; w.x = cvtpk2(a[0], a[1]); w.y = cvtpk2(a[2], a[3]); w.z = cvtpk2(b[0], b[1]); w.w = cvtpk2(b[2], b[3]); return w; }
__device__ __forceinline__ void rope8(f32x4& v0, f32x4& v1, const f32x4 c4, const f32x4 s4) {
    const f32x4 a = (f32x4){v0[0], v0[2], v1[0], v1[2]}, b = (f32x4){v0[1], v0[3], v1[1], v1[3]};
    const f32x4 x = a * c4 - b * s4, y = b * c4 + a * s4;
    v0 = (f32x4){x[0], y[0], x[1], y[1]}; v1 = (f32x4){x[2], y[2], x[3], y[3]}; }
__device__ __forceinline__ float sq8(const f32x4 a, const f32x4 b) { return (a[0] * a[0] + a[1] * a[1]) + (a[2] * a[2] + a[3] * a[3]) + (b[0] * b[0] + b[1] * b[1]) + (b[2] * b[2] + b[3] * b[3]); }
#define EPI_FENCE() asm volatile("" ::: "memory")
__device__ __forceinline__ void load_rs(float (&rs)[2][4], const float* ssq, int row0, float inv_kd) {
    float t[2][4];
#pragma unroll
    for (int ai = 0; ai < 2; ++ai)
#pragma unroll
        for (int m = 0; m < 4; ++m) t[ai][m] = ssq[row0 + ai * HALF + m * 16];
#pragma unroll
    for (int ai = 0; ai < 2; ++ai)
#pragma unroll
        for (int m = 0; m < 4; ++m) rs[ai][m] = rsqrtf(t[ai][m] * inv_kd + 1e-6f);
}

struct EpiQKV {
    static constexpr bool PERM = true, AFTER_DRAIN = false;
    bf16_t* O; const float* ssq; const float* cs; const float* sn; float qscale;
    __device__ __forceinline__ void operator()(const f32x4 (&acc)[2][2][4][2], const Unit& u, int wr, int wc, int fr, int fq) const {
        const int row0 = u.pm * BM + wr * 64 + fr, colt = u.pn * BM, region = colt >> 10;
        const int col0 = colt + wc * 32 + 8 * fq, j0 = (wc & 1) * 16 + 4 * fq;
        float rs[2][4]; load_rs(rs, ssq, row0, 1.0f / 1024.0f);
        const float qs = region == 0 ? qscale : 1.f;
#pragma unroll
        for (int ai = 0; ai < 2; ++ai) {
            f32x4 c4[4], s4[4];
            if (region < 2) {
#pragma unroll
                for (int m = 0; m < 4; ++m) { const int pos = (row0 + ai * HALF + m * 16) & 4095; c4[m] = *(const f32x4*)(cs + pos * 32 + j0); s4[m] = *(const f32x4*)(sn + pos * 32 + j0); }
            }
#pragma unroll
            for (int m = 0; m < 4; ++m) {
                const int row = row0 + ai * HALF + m * 16; const float r = rs[ai][m] * qs;
                bf16_t* rowp = O + (size_t)row * 3072 + col0;
#pragma unroll
                for (int bj = 0; bj < 2; ++bj) { f32x4 v0 = acc[ai][bj][m][0] * r, v1 = acc[ai][bj][m][1] * r;
                    if (region < 2) rope8(v0, v1, c4[m], s4[m]);
                    *(u32x4*)(rowp + bj * HALF) = pack8(v0, v1); }
            }
            EPI_FENCE();
        }
    }
};
struct EpiRes {
    static constexpr bool PERM = true, AFTER_DRAIN = false;
    bf16_t* hb; float* ssq;
    __device__ __forceinline__ void operator()(const f32x4 (&acc)[2][2][4][2], const Unit& u, int wr, int wc, int fr, int fq) const {
        const int row0 = u.pm * BM + wr * 64 + fr, col0 = u.pn * BM + wc * 32 + 8 * fq;
#pragma unroll
        for (int ai = 0; ai < 2; ++ai) {
            u32x4 bw[4][2];
#pragma unroll
            for (int m = 0; m < 4; ++m)
#pragma unroll
                for (int bj = 0; bj < 2; ++bj) bw[m][bj] = *(const u32x4*)(hb + (size_t)(row0 + ai * HALF + m * 16) * 1024 + col0 + bj * HALF);
#pragma unroll
            for (int m = 0; m < 4; ++m) {
                const int row = row0 + ai * HALF + m * 16; const size_t off = (size_t)row * 1024 + col0; float s = 0.f;
#pragma unroll
                for (int bj = 0; bj < 2; ++bj) { const u32x4 w = bw[m][bj];
                    const f32x4 b0 = (f32x4){__uint_as_float(w.x << 16), __uint_as_float(w.x & 0xffff0000u), __uint_as_float(w.y << 16), __uint_as_float(w.y & 0xffff0000u)};
                    const f32x4 b1 = (f32x4){__uint_as_float(w.z << 16), __uint_as_float(w.z & 0xffff0000u), __uint_as_float(w.w << 16), __uint_as_float(w.w & 0xffff0000u)};
                    const f32x4 v0 = acc[ai][bj][m][0] + b0, v1 = acc[ai][bj][m][1] + b1;
                    *(u32x4*)(hb + off + bj * HALF) = pack8(v0, v1);
                    s += sq8(v0, v1); }
                s += __shfl_xor(s, 16); s += __shfl_xor(s, 32);
                if (fq == 0) atomicAdd(ssq + row, s);
            }
            EPI_FENCE();
        }
    }
};
struct EpiResFinal {
    static constexpr bool PERM = true, AFTER_DRAIN = false;
    const bf16_t* hb; float* ssq; unsigned* cnt; float* out; const float* g;
    __device__ __forceinline__ void operator()(f32x4 (&acc)[2][2][4][2], const Unit& u, int wr, int wc, int fr, int fq) const {
        const int row0 = u.pm * BM + wr * 64 + fr, col0 = u.pn * BM + wc * 32 + 8 * fq;
#pragma unroll
        for (int ai = 0; ai < 2; ++ai) {
            u32x4 bw[4][2];
#pragma unroll
            for (int m = 0; m < 4; ++m)
#pragma unroll
                for (int bj = 0; bj < 2; ++bj) bw[m][bj] = *(const u32x4*)(hb + (size_t)(row0 + ai * HALF + m * 16) * 1024 + col0 + bj * HALF);
#pragma unroll
            for (int m = 0; m < 4; ++m) {
                const int row = row0 + ai * HALF + m * 16; float s = 0.f;
#pragma unroll
                for (int bj = 0; bj < 2; ++bj) { const u32x4 w = bw[m][bj];
                    const f32x4 b0 = (f32x4){__uint_as_float(w.x << 16), __uint_as_float(w.x & 0xffff0000u), __uint_as_float(w.y << 16), __uint_as_float(w.y & 0xffff0000u)};
                    const f32x4 b1 = (f32x4){__uint_as_float(w.z << 16), __uint_as_float(w.z & 0xffff0000u), __uint_as_float(w.w << 16), __uint_as_float(w.w & 0xffff0000u)};
                    acc[ai][bj][m][0] += b0; acc[ai][bj][m][1] += b1;
                    s += sq8(acc[ai][bj][m][0], acc[ai][bj][m][1]); }
                s += __shfl_xor(s, 16); s += __shfl_xor(s, 32);
                if (fq == 0) __hip_atomic_fetch_add(ssq + row, s, __ATOMIC_RELAXED, __HIP_MEMORY_SCOPE_AGENT);
            }
            EPI_FENCE();
        }
        asm volatile("s_waitcnt vmcnt(0)" ::: "memory");
        unsigned* c = cnt + 64 * u.pm;
        if (fr == 0 && fq == 0) __hip_atomic_fetch_add(c, 1u, __ATOMIC_RELAXED, __HIP_MEMORY_SCOPE_AGENT);
        { unsigned spins = 0; while (__hip_atomic_load(c, __ATOMIC_RELAXED, __HIP_MEMORY_SCOPE_AGENT) < 32u && ++spins < (1u << 22)) __builtin_amdgcn_s_sleep(2); }
        asm volatile("" ::: "memory");
        float rs[2][4];
#pragma unroll
        for (int ai = 0; ai < 2; ++ai)
#pragma unroll
            for (int m = 0; m < 4; ++m) rs[ai][m] = rsqrtf(__hip_atomic_load(ssq + row0 + ai * HALF + m * 16, __ATOMIC_RELAXED, __HIP_MEMORY_SCOPE_AGENT) * (1.0f / 1024.0f) + 1e-6f);
        f32x4 gv[2][2];
#pragma unroll
        for (int bj = 0; bj < 2; ++bj) { gv[bj][0] = *(const f32x4*)(g + col0 + bj * HALF); gv[bj][1] = *(const f32x4*)(g + col0 + bj * HALF + 4); }
#pragma unroll
        for (int ai = 0; ai < 2; ++ai)
#pragma unroll
            for (int m = 0; m < 4; ++m) { float* rowp = out + (size_t)(row0 + ai * HALF + m * 16) * 1024 + col0; const float r = rs[ai][m];
#pragma unroll
                for (int bj = 0; bj < 2; ++bj) { *(f32x4*)(rowp + bj * HALF) = acc[ai][bj][m][0] * r * gv[bj][0]; *(f32x4*)(rowp + bj * HALF + 4) = acc[ai][bj][m][1] * r * gv[bj][1]; } }
    }
};
struct EpiUp {
    static constexpr bool PERM = true, AFTER_DRAIN = false;
    bf16_t* O; const float* ssq;
    __device__ __forceinline__ void operator()(const f32x4 (&acc)[2][2][4][2], const Unit& u, int wr, int wc, int fr, int fq) const {
        const int row0 = u.pm * BM + wr * 64 + fr, col0 = u.pn * BM + wc * 32 + 8 * fq;
        float rs[2][4]; load_rs(rs, ssq, row0, 1.0f / 1024.0f);
#pragma unroll
        for (int ai = 0; ai < 2; ++ai)
#pragma unroll
            for (int m = 0; m < 4; ++m) {
                const int row = row0 + ai * HALF + m * 16; const float r = rs[ai][m];
                bf16_t* rowp = O + (size_t)row * 4096 + col0;
#pragma unroll
                for (int bj = 0; bj < 2; ++bj) { f32x4 v0 = acc[ai][bj][m][0] * r, v1 = acc[ai][bj][m][1] * r;
#pragma unroll
                    for (int e = 0; e < 4; ++e) { const float a = fmaxf(v0[e], 0.f), b = fmaxf(v1[e], 0.f); v0[e] = a * a; v1[e] = b * b; }
                    *(u32x4*)(rowp + bj * HALF) = pack8(v0, v1); }
            }
    }
};
struct EpiDkvq {
    static constexpr bool PERM = true, AFTER_DRAIN = false;
    bf16_t* Cb; bf16_t* KR; bf16_t* CQ; const float* ssq; float* ssq_c; float* ssq_q; const float* cs; const float* sn;
    __device__ __forceinline__ void operator()(const f32x4 (&acc)[2][2][4][2], const Unit& u, int wr, int wc, int fr, int fq) const {
        const int row0 = u.pm * BM + wr * 64 + fr;
        float rs[2][4]; load_rs(rs, ssq, row0, 1.0f / 1024.0f);
#pragma unroll
        for (int bj = 0; bj < 2; ++bj) {
            const int g = u.pn * BM + bj * HALF + wc * 32;
            if (g >= 704) continue;
            const bool isrope = (g >= 256 && g < 320);
#pragma unroll
            for (int ai = 0; ai < 2; ++ai) {
                f32x4 c4[4], s4[4];
                if (isrope) { const int j0 = ((g - 256) >> 1) + 4 * fq;
#pragma unroll
                    for (int m = 0; m < 4; ++m) { const int pos = (row0 + ai * HALF + m * 16) & 4095; c4[m] = *(const f32x4*)(cs + pos * 32 + j0); s4[m] = *(const f32x4*)(sn + pos * 32 + j0); } }
#pragma unroll
                for (int m = 0; m < 4; ++m) {
                    const int row = row0 + ai * HALF + m * 16; const float r = rs[ai][m];
                    f32x4 v0 = acc[ai][bj][m][0] * r, v1 = acc[ai][bj][m][1] * r;
                    if (g < 256) {
                        *(u32x4*)(Cb + (size_t)row * 256 + g + 8 * fq) = pack8(v0, v1);
                        float s = sq8(v0, v1); s += __shfl_xor(s, 16); s += __shfl_xor(s, 32); if (fq == 0) atomicAdd(ssq_c + row, s);
                    } else if (isrope) {
                        rope8(v0, v1, c4[m], s4[m]);
                        *(u32x4*)(KR + (size_t)row * 64 + (g - 256) + 8 * fq) = pack8(v0, v1);
                    } else {
                        *(u32x4*)(CQ + (size_t)row * 384 + (g - 320) + 8 * fq) = pack8(v0, v1);
                        float s = sq8(v0, v1); s += __shfl_xor(s, 16); s += __shfl_xor(s, 32); if (fq == 0) atomicAdd(ssq_q + row, s);
                    }
                }
                EPI_FENCE();
            }
        }
    }
};
template <bool ROPE192, int LDC> struct EpiLat {
    static constexpr bool PERM = true, AFTER_DRAIN = false;
    bf16_t* O; const float* ssq; float inv_kd; float scale; const float* cs; const float* sn;
    __device__ __forceinline__ void operator()(const f32x4 (&acc)[2][2][4][2], const Unit& u, int wr, int wc, int fr, int fq) const {
        const int row0 = u.pm * BM + wr * 64 + fr;
        float rs[2][4]; load_rs(rs, ssq, row0, inv_kd);
#pragma unroll
        for (int bj = 0; bj < 2; ++bj) {
            const int g = u.pn * BM + bj * HALF + wc * 32; const int hc = g % 192; const bool isrope = ROPE192 && hc >= 128;
#pragma unroll
            for (int ai = 0; ai < 2; ++ai) {
                f32x4 c4[4], s4[4];
                if (isrope) { const int j0 = ((hc - 128) >> 1) + 4 * fq;
#pragma unroll
                    for (int m = 0; m < 4; ++m) { const int pos = (row0 + ai * HALF + m * 16) & 4095; c4[m] = *(const f32x4*)(cs + pos * 32 + j0); s4[m] = *(const f32x4*)(sn + pos * 32 + j0); } }
#pragma unroll
                for (int m = 0; m < 4; ++m) {
                    const int row = row0 + ai * HALF + m * 16; const float r = rs[ai][m] * scale;
                    f32x4 v0 = acc[ai][bj][m][0] * r, v1 = acc[ai][bj][m][1] * r;
                    if (isrope) rope8(v0, v1, c4[m], s4[m]);
                    *(u32x4*)(O + (size_t)row * LDC + g + 8 * fq) = pack8(v0, v1);
                }
                EPI_FENCE();
            }
        }
    }
};
#undef EPI_FENCE
}
namespace att {
typedef unsigned short bf16_t;
typedef short bf16x8 __attribute__((ext_vector_type(8)));
typedef short s16x4 __attribute__((ext_vector_type(4)));
typedef float f32x16 __attribute__((ext_vector_type(16)));
typedef float f32x4 __attribute__((ext_vector_type(4)));
typedef unsigned u32x4 __attribute__((ext_vector_type(4)));
#define SBAR() __builtin_amdgcn_sched_barrier(0)
constexpr int SHM_V = 16384;
constexpr float THR = 8.f;
__device__ __forceinline__ int v_st(int k, int c) { const int kk = (k & ~0xC) | ((k & 4) << 1) | ((k & 8) >> 1); return ((kk >> 3) * 4 + (c >> 5)) * 512 + ((kk & 7) * 32 + (c & 31)) * 2; }
__device__ __forceinline__ int v_rd_base(int lane) { return ((lane & 3) << 3) | (((lane >> 2) & 3) << 6) | (((lane >> 4) & 1) << 5) | (((lane >> 5) & 1) << 8); }
__device__ __forceinline__ int crow(int r, int hi) { return (r & 3) + 8 * (r >> 2) + 4 * hi; }
typedef float f32x2_t __attribute__((ext_vector_type(2))); typedef __bf16 bf16x2_t __attribute__((ext_vector_type(2)));
__device__ __forceinline__ unsigned cvtpk(float lo, float hi) { f32x2_t v = {lo, hi}; bf16x2_t b = __builtin_convertvector(v, bf16x2_t); return __builtin_bit_cast(unsigned, b); }
template <int ROWB> __device__ __forceinline__ int kswz(int row, int colB) { return row * ROWB + (colB ^ ((row & (ROWB == 256 ? 15 : 7)) << 4)); }

__device__ __forceinline__ void mask_tile(f32x16& p0, f32x16& p1, int dq) {
    const float NEG = -__builtin_inff();
#pragma unroll
    for (int r = 0; r < 16; ++r) { const int c = (r & 3) + 8 * (r >> 2); if (dq - c < 0) p0[r] = NEG; if (dq - c - 32 < 0) p1[r] = NEG; }
}
template <int NQ, int ROWB>
__device__ __forceinline__ void qkt(f32x16& p0, f32x16& p1, const char* Kt, int cofs, int r32, int hi, const bf16x8* qr) {
    constexpr int GS = (NQ > 4) ? 2 : 4, NG = NQ / GS;
    const char* kb[4];
#pragma unroll
    for (int dd = 0; dd < 4; ++dd) kb[dd] = Kt + kswz<ROWB>(r32, cofs + (dd * 16 + hi * 8) * 2);
    bf16x8 kf[2][2 * GS];
#define KLD(g, bufi) do { _Pragma("unroll") for (int e = 0; e < GS; ++e) { const int d0_ = (g) * GS + e; const char* a_ = kb[d0_ & 3] + (d0_ >> 2) * 128; \
        kf[bufi][2 * e] = *reinterpret_cast<const bf16x8*>(a_); kf[bufi][2 * e + 1] = *reinterpret_cast<const bf16x8*>(a_ + 32 * ROWB); } } while (0)
    KLD(0, 0);
#pragma unroll
    for (int g = 0; g < NG; ++g) {
        if (g + 1 < NG) KLD(g + 1, (g + 1) & 1);
        SBAR();
#pragma unroll
        for (int e = 0; e < GS; ++e) {
            if (g == 0 && e == 0) { p0 = __builtin_amdgcn_mfma_f32_32x32x16_bf16(kf[0][0], qr[0], f32x16{}, 0, 0, 0); p1 = __builtin_amdgcn_mfma_f32_32x32x16_bf16(kf[0][1], qr[0], f32x16{}, 0, 0, 0); }
            else { p0 = __builtin_amdgcn_mfma_f32_32x32x16_bf16(kf[g & 1][2 * e], qr[g * GS + e], p0, 0, 0, 0); p1 = __builtin_amdgcn_mfma_f32_32x32x16_bf16(kf[g & 1][2 * e + 1], qr[g * GS + e], p1, 0, 0, 0); }
        }
        SBAR();
    }
#undef KLD
}
__device__ __forceinline__ void pv_tile(f32x16* o, int vb, bf16x8 pa0, bf16x8 pa1, bf16x8 pa2, bf16x8 pa3) {
#define TRRD(dst, off) asm volatile("ds_read_b64_tr_b16 %0, %1 offset:%2" : "=&v"(dst) : "v"(vb), "i"(off) : "memory")
#define PV_RD(X, d0) do { constexpr int b_ = (d0) * 512; \
        TRRD(X##l0, b_); TRRD(X##h0, b_ + 2048); TRRD(X##l1, b_ + 4096); TRRD(X##h1, b_ + 6144); TRRD(X##l2, b_ + 8192); TRRD(X##h2, b_ + 10240); TRRD(X##l3, b_ + 12288); TRRD(X##h3, b_ + 14336); } while (0)
#define PV_MM(X, d0) do { \
        o[d0] = __builtin_amdgcn_mfma_f32_32x32x16_bf16(pa0, (bf16x8){X##l0[0], X##l0[1], X##l0[2], X##l0[3], X##h0[0], X##h0[1], X##h0[2], X##h0[3]}, o[d0], 0, 0, 0); \
        o[d0] = __builtin_amdgcn_mfma_f32_32x32x16_bf16(pa1, (bf16x8){X##l1[0], X##l1[1], X##l1[2], X##l1[3], X##h1[0], X##h1[1], X##h1[2], X##h1[3]}, o[d0], 0, 0, 0); \
        o[d0] = __builtin_amdgcn_mfma_f32_32x32x16_bf16(pa2, (bf16x8){X##l2[0], X##l2[1], X##l2[2], X##l2[3], X##h2[0], X##h2[1], X##h2[2], X##h2[3]}, o[d0], 0, 0, 0); \
        o[d0] = __builtin_amdgcn_mfma_f32_32x32x16_bf16(pa3, (bf16x8){X##l3[0], X##l3[1], X##l3[2], X##l3[3], X##h3[0], X##h3[1], X##h3[2], X##h3[3]}, o[d0], 0, 0, 0); } while (0)
    s16x4 al0, al1, al2, al3, ah0, ah1, ah2, ah3, bl0, bl1, bl2, bl3, bh0, bh1, bh2, bh3;
    PV_RD(a, 0); PV_RD(b, 1);
    asm volatile("s_waitcnt lgkmcnt(8)" ::: "memory"); SBAR(); PV_MM(a, 0); SBAR();
    PV_RD(a, 2);
    asm volatile("s_waitcnt lgkmcnt(8)" ::: "memory"); SBAR(); PV_MM(b, 1); SBAR();
    PV_RD(b, 3);
    asm volatile("s_waitcnt lgkmcnt(8)" ::: "memory"); SBAR(); PV_MM(a, 2); SBAR();
    asm volatile("s_waitcnt lgkmcnt(0)" ::: "memory"); SBAR(); PV_MM(b, 3);
#undef PV_RD
#undef PV_MM
#undef TRRD
}
__device__ __forceinline__ void softmax_tile(f32x16& p0, f32x16& p1, float& m_reg, float& l_reg, f32x16* o, float* al_l, int r32, int hi,
                                             bf16x8& pa0, bf16x8& pa1, bf16x8& pa2, bf16x8& pa3) {
    float pmax = p0[0];
#pragma unroll
    for (int r = 1; r < 16; ++r) pmax = fmaxf(pmax, p0[r]);
#pragma unroll
    for (int r = 0; r < 16; ++r) pmax = fmaxf(pmax, p1[r]);
    { auto rr = __builtin_amdgcn_permlane32_swap(__float_as_uint(pmax), __float_as_uint(pmax), false, false);
      pmax = fmaxf(__uint_as_float(rr[0]), __uint_as_float(rr[1])); }
    if (!__all(pmax - m_reg <= THR)) {
        const float mn = fmaxf(m_reg, pmax); const float alpha = __builtin_amdgcn_exp2f(m_reg - mn); m_reg = mn; l_reg *= alpha;
        if (hi == 0) al_l[r32] = alpha;
        asm volatile("s_waitcnt lgkmcnt(0)" ::: "memory");
#pragma unroll
        for (int g = 0; g < 4; ++g) { const f32x4 a4 = *(const f32x4*)(al_l + 8 * g + 4 * hi);
#pragma unroll
            for (int d = 0; d < 4; ++d)
#pragma unroll
                for (int e = 0; e < 4; ++e) o[d][4 * g + e] *= a4[e]; }
    }
    float ps = 0.f;
#pragma unroll
    for (int r = 0; r < 16; ++r) { p0[r] = __builtin_amdgcn_exp2f(p0[r] - m_reg); ps += p0[r]; }
#pragma unroll
    for (int r = 0; r < 16; ++r) { p1[r] = __builtin_amdgcn_exp2f(p1[r] - m_reg); ps += p1[r]; }
    l_reg += ps;
#define PK4(P, B_, OUT) do { u32x4 w = {cvtpk(P[B_+0], P[B_+1]), cvtpk(P[B_+2], P[B_+3]), cvtpk(P[B_+4], P[B_+5]), cvtpk(P[B_+6], P[B_+7])}; OUT = *reinterpret_cast<bf16x8*>(&w); } while (0)
    PK4(p0, 0, pa0); PK4(p0, 8, pa1); PK4(p1, 0, pa2); PK4(p1, 8, pa3);
#undef PK4
}

template <int ROWB>
__device__ __forceinline__ void qk_sm_interleaved(f32x16& n0, f32x16& n1, f32x16& c0, f32x16& c1, const char* Kt, int cofs, int r32, int hi, const bf16x8* qr,
                                                  float& m_reg, float& l_reg, f32x16* o, float* al_l, bf16x8& pa0, bf16x8& pa1, bf16x8& pa2, bf16x8& pa3) {
    bf16x8 kf[8];
#pragma unroll
    for (int dd = 0; dd < 4; ++dd) { const char* a_ = Kt + kswz<ROWB>(r32, cofs + (dd * 16 + hi * 8) * 2);
        kf[2 * dd] = *reinterpret_cast<const bf16x8*>(a_); kf[2 * dd + 1] = *reinterpret_cast<const bf16x8*>(a_ + 32 * ROWB); }
    SBAR();
    n0 = __builtin_amdgcn_mfma_f32_32x32x16_bf16(kf[0], qr[0], f32x16{}, 0, 0, 0); n1 = __builtin_amdgcn_mfma_f32_32x32x16_bf16(kf[1], qr[0], f32x16{}, 0, 0, 0);
    SBAR();
    float pmax = c0[0];
#pragma unroll
    for (int r = 1; r < 16; ++r) pmax = fmaxf(pmax, c0[r]);
    SBAR();
    n0 = __builtin_amdgcn_mfma_f32_32x32x16_bf16(kf[2], qr[1], n0, 0, 0, 0); n1 = __builtin_amdgcn_mfma_f32_32x32x16_bf16(kf[3], qr[1], n1, 0, 0, 0);
    SBAR();
#pragma unroll
    for (int r = 0; r < 16; ++r) pmax = fmaxf(pmax, c1[r]);
    { auto rr = __builtin_amdgcn_permlane32_swap(__float_as_uint(pmax), __float_as_uint(pmax), false, false);
      pmax = fmaxf(__uint_as_float(rr[0]), __uint_as_float(rr[1])); }
    if (!__all(pmax - m_reg <= THR)) {
        const float mn = fmaxf(m_reg, pmax); const float alpha = __builtin_amdgcn_exp2f(m_reg - mn); m_reg = mn; l_reg *= alpha;
        if (hi == 0) al_l[r32] = alpha;
        asm volatile("s_waitcnt lgkmcnt(0)" ::: "memory");
#pragma unroll
        for (int g = 0; g < 4; ++g) { const f32x4 a4 = *(const f32x4*)(al_l + 8 * g + 4 * hi);
#pragma unroll
            for (int d = 0; d < 4; ++d)
#pragma unroll
                for (int e = 0; e < 4; ++e) o[d][4 * g + e] *= a4[e]; }
    }
    SBAR();
    n0 = __builtin_amdgcn_mfma_f32_32x32x16_bf16(kf[4], qr[2], n0, 0, 0, 0); n1 = __builtin_amdgcn_mfma_f32_32x32x16_bf16(kf[5], qr[2], n1, 0, 0, 0);
    SBAR();
    float ps = 0.f;
#pragma unroll
    for (int r = 0; r < 16; ++r) { c0[r] = __builtin_amdgcn_exp2f(c0[r] - m_reg); ps += c0[r]; }
    SBAR();
    n0 = __builtin_amdgcn_mfma_f32_32x32x16_bf16(kf[6], qr[3], n0, 0, 0, 0); n1 = __builtin_amdgcn_mfma_f32_32x32x16_bf16(kf[7], qr[3], n1, 0, 0, 0);
    SBAR();
#pragma unroll
    for (int r = 0; r < 16; ++r) { c1[r] = __builtin_amdgcn_exp2f(c1[r] - m_reg); ps += c1[r]; }
    l_reg += ps;
#define PK4(P, B_, OUT) do { u32x4 w = {cvtpk(P[B_+0], P[B_+1]), cvtpk(P[B_+2], P[B_+3]), cvtpk(P[B_+4], P[B_+5]), cvtpk(P[B_+6], P[B_+7])}; OUT = *reinterpret_cast<bf16x8*>(&w); } while (0)
    PK4(c0, 0, pa0); PK4(c0, 8, pa1); PK4(c1, 0, pa2); PK4(c1, 8, pa3);
#undef PK4
}
#define ATT_LAS __attribute__((address_space(3)))
template <int MODE>
__device__ __forceinline__ void attn_unit(char* lds, ATT_LAS unsigned char* lds3, const bf16_t* Qb, const bf16_t* Kb, const bf16_t* KRb, const bf16_t* Vb, bf16_t* Ob, int q0, float lam, const float* subg) {
    constexpr int QP = MODE ? 1536 : 3072, KP = MODE ? 2048 : 3072, VP = KP, OP = 1024, NQ = MODE ? 12 : 4, ROWB = MODE ? 384 : 256, UROWS = MODE ? 256 : 128, SHM_K = 64 * ROWB;
    constexpr int NKS = MODE ? 3 : 2;
    const int tid = threadIdx.x, wid = __builtin_amdgcn_readfirstlane(tid >> 6), lane = tid & 63, r32 = lane & 31, hi = lane >> 5;
    const int comp = MODE ? 0 : (wid & 1), rg = MODE ? wid : (wid >> 1);
    const int qrow0 = q0 + rg * 32;
    const int NT = (q0 + UROWS) / 64;
    char* V_lds = lds; char* K_lds = lds + 2 * SHM_V;
    float* wsf = (float*)(lds + 2 * SHM_V + 2 * SHM_K) + wid * 64; float* li_l = wsf; float* al_l = wsf + 32;
    const bf16_t* ksrc[NKS]; int kstr[NKS]; int voff[2];
#pragma unroll
    for (int j = 0; j < NKS; ++j) {
        if (MODE) { const int cidx = 64 * (wid * 3 + j) + lane, row = cidx / 24, pc = cidx - row * 24, lc = (pc & ~7) | ((pc & 7) ^ (row & 7));
            if (lc < 16) { ksrc[j] = Kb + (size_t)row * KP + lc * 8; kstr[j] = 64 * KP; } else { ksrc[j] = KRb + (size_t)row * 64 + (lc - 16) * 8; kstr[j] = 64 * 64; } }
        else { const int row = 4 * (wid * 2 + j) + (lane >> 4), pc = lane & 15, lc = pc ^ (row & 15); ksrc[j] = Kb + (size_t)row * KP + lc * 8; kstr[j] = 64 * KP; }
    }
#pragma unroll
    for (int j = 0; j < 2; ++j) { const int q = 64 * (wid * 2 + j) + lane, st = q >> 5, w = q & 31, kk = ((st >> 2) << 3) | (w >> 2);
        const int k = kk, c = (st & 3) * 32 + (w & 3) * 8; voff[j] = k * VP + c; }
#define DMA_K(t, bf) do { _Pragma("unroll") for (int j_ = 0; j_ < NKS; ++j_) \
        __builtin_amdgcn_global_load_lds((const unsigned*)(ksrc[j_] + (size_t)(t) * kstr[j_]), (ATT_LAS unsigned*)(lds3 + 2 * SHM_V + (bf) * SHM_K + (wid * NKS + j_) * 1024), 16, 0, 0); } while (0)
#define DMA_V(t, bf) do { _Pragma("unroll") for (int j_ = 0; j_ < 2; ++j_) \
        __builtin_amdgcn_global_load_lds((const unsigned*)(Vb + (size_t)(t) * 64 * VP + voff[j_]), (ATT_LAS unsigned*)(lds3 + (bf) * SHM_V + (wid * 2 + j_) * 1024), 16, 0, 0); } while (0)
    constexpr bool PIPE = (MODE == 0);
    DMA_K(0, 0); DMA_V(0, 0); if (PIPE) DMA_K(1, 1);
    bf16x8 qr[NQ];
#pragma unroll
    for (int d0 = 0; d0 < NQ; ++d0) qr[d0] = *reinterpret_cast<const bf16x8*>(Qb + (size_t)(qrow0 + r32) * QP + comp * 64 + d0 * 16 + hi * 8);
    const int vb0 = (int)(uintptr_t)V_lds + v_rd_base(lane);
    float m_reg = -1e30f, l_reg = 0.f; f32x16 o[4] = {};
#pragma unroll
    for (int d0 = 0; d0 < NQ; ++d0) asm volatile("" :: "v"(qr[d0]));
    asm volatile("s_waitcnt vmcnt(0)" ::: "memory");
    __syncthreads();
    f32x16 sA0, sA1, sB0, sB1;
    if (PIPE) qkt<NQ, ROWB>(sA0, sA1, K_lds, comp * 128, r32, hi, qr);
    if (PIPE) { asm volatile("s_waitcnt lgkmcnt(0)" ::: "memory"); __syncthreads(); }
#define STEP(C0, C1, N0, N1, t, P) do { \
        const int kb_ = (t) * 64; \
        if (PIPE) { if ((t) + 2 < NT) DMA_K((t) + 2, P); } else { if ((t) + 1 < NT) DMA_K((t) + 1, 1 - (P)); } \
        if ((t) + 1 < NT) DMA_V((t) + 1, 1 - (P)); \
        if (PIPE) { if ((t) + 1 < NT && kb_ + 64 <= qrow0 + 31) qkt<NQ, ROWB>(N0, N1, K_lds + (1 - (P)) * SHM_K, comp * 128, r32, hi, qr); } \
        if (kb_ <= qrow0 + 31) { bf16x8 pa0, pa1, pa2, pa3; \
            if (!PIPE) qkt<NQ, ROWB>(C0, C1, K_lds + (P) * SHM_K, comp * 128, r32, hi, qr); \
            if (kb_ + 63 > qrow0) mask_tile(C0, C1, qrow0 + r32 - kb_ - 4 * hi); \
            softmax_tile(C0, C1, m_reg, l_reg, o, al_l, r32, hi, pa0, pa1, pa2, pa3); \
            SBAR(); \
            pv_tile(o, vb0 + (P) * SHM_V, pa0, pa1, pa2, pa3); } \
        asm volatile("s_waitcnt vmcnt(0)" ::: "memory"); \
        __syncthreads(); } while (0)
#define ISTEP(C0, C1, N0, N1, t, P) do { bf16x8 pa0, pa1, pa2, pa3; \
        DMA_K((t) + 2, P); DMA_V((t) + 1, 1 - (P)); \
        qk_sm_interleaved<ROWB>(N0, N1, C0, C1, K_lds + (1 - (P)) * SHM_K, comp * 128, r32, hi, qr, m_reg, l_reg, o, al_l, pa0, pa1, pa2, pa3); \
        SBAR(); \
        pv_tile(o, vb0 + (P) * SHM_V, pa0, pa1, pa2, pa3); \
        asm volatile("s_waitcnt vmcnt(0)" ::: "memory"); \
        __syncthreads(); } while (0)
    if (PIPE) {
        const int NTI = NT - 2;
#pragma unroll 1
        for (int t = 0; t < NTI; t += 2) { ISTEP(sA0, sA1, sB0, sB1, t, 0); ISTEP(sB0, sB1, sA0, sA1, t + 1, 1); }
        STEP(sA0, sA1, sB0, sB1, NTI, 0); STEP(sB0, sB1, sA0, sA1, NTI + 1, 1);
    } else {
#pragma unroll 1
        for (int t = 0; t < NT; t += 2) { STEP(sA0, sA1, sA0, sA1, t, 0); STEP(sA0, sA1, sA0, sA1, t + 1, 1); }
    }
#undef ISTEP
#undef STEP
#undef DMA_K
#undef DMA_V
    { auto rr = __builtin_amdgcn_permlane32_swap(__float_as_uint(l_reg), __float_as_uint(l_reg), false, false); l_reg = __uint_as_float(rr[0]) + __uint_as_float(rr[1]); }
    if (hi == 0) li_l[r32] = l_reg;
    asm volatile("s_waitcnt lgkmcnt(0)" ::: "memory");
#pragma unroll
    for (int g = 0; g < 4; ++g) { const f32x4 l4 = *(const f32x4*)(li_l + 8 * g + 4 * hi);
#pragma unroll
        for (int e = 0; e < 4; ++e) { const float rl = __builtin_amdgcn_rcpf(l4[e]);
#pragma unroll
            for (int d = 0; d < 4; ++d) o[d][4 * g + e] *= rl; } }
    bf16_t* Ow = Ob + (size_t)qrow0 * OP;
    if (MODE) {
#pragma unroll
        for (int r = 0; r < 16; ++r) { const int orow = crow(r, hi);
#pragma unroll
            for (int d0 = 0; d0 < 4; ++d0) Ow[(size_t)orow * OP + d0 * 32 + r32] = (bf16_t)(cvtpk(o[d0][r], o[d0][r]) & 0xffffu); }
    } else {
        float* xb = (float*)lds + rg * 4096;
        if (comp == 1) {
#pragma unroll
            for (int d0 = 0; d0 < 4; ++d0)
#pragma unroll
                for (int r = 0; r < 16; ++r) xb[(d0 * 16 + r) * 64 + lane] = o[d0][r] * lam;
        }
        __syncthreads();
        if (comp == 0) {
            float s[16];
#pragma unroll
            for (int r = 0; r < 16; ++r) { float a = 0.f;
#pragma unroll
                for (int d0 = 0; d0 < 4; ++d0) { const float dv = o[d0][r] - xb[(d0 * 16 + r) * 64 + lane]; o[d0][r] = dv; a += dv * dv; }
                s[r] = a; }
#pragma unroll
            for (int off = 1; off < 32; off <<= 1)
#pragma unroll
                for (int r = 0; r < 16; ++r) s[r] += __shfl_xor(s[r], off);
            float gg[4];
#pragma unroll
            for (int d0 = 0; d0 < 4; ++d0) gg[d0] = subg[d0 * 32 + r32] * 0.8f;
#pragma unroll
            for (int r = 0; r < 16; ++r) { const int orow = crow(r, hi); const float rs = rsqrtf(s[r] * (1.0f / 128.0f) + 1e-5f);
#pragma unroll
                for (int d0 = 0; d0 < 4; ++d0) { const float v = o[d0][r] * rs * gg[d0]; Ow[(size_t)orow * OP + d0 * 32 + r32] = (bf16_t)(cvtpk(v, v) & 0xffffu); } }
        }
        __syncthreads();
    }
}
#undef SBAR
}
#ifndef MK_SINGLE
#define MK_SINGLE 1
#endif
constexpr int NWAVES = 8;
constexpr int BATCH = 8, SEQ = 4096, DM = 1024, M = BATCH * SEQ, FF = 4096;
constexpr int NQKV = 3072, NDKVQ = 768, KVL = 256, QL = 384, NUKV = 2048, NUQ = 1536;
constexpr int NPHASE = 13;
constexpr size_t MiB = 1u << 20;
constexpr size_t WS_WQKV = 2 * MiB, WS_WOA = 8 * MiB, WS_WUP0 = 10 * MiB, WS_WDN0 = 18 * MiB, WS_WDKVQ = 26 * MiB, WS_WUKV = 28 * MiB, WS_WUQ = 29 * MiB,
                 WS_WOB = 31 * MiB, WS_WUP1 = 33 * MiB, WS_WDN1 = 41 * MiB;
constexpr size_t WS_COS = 49 * MiB, WS_SIN = WS_COS + 512 * 1024, WS_SSQ = 50 * MiB;
constexpr size_t WS_HB = 64 * MiB;
constexpr size_t WS_R1 = 128 * MiB;
constexpr size_t WS_KV = WS_R1, WS_QB = WS_R1 + 128 * MiB, WS_CB = WS_R1 + 224 * MiB, WS_KR = WS_R1 + 240 * MiB;
constexpr size_t WS_O = 384 * MiB, WS_CQ = 448 * MiB, WS_END = 472 * MiB;
constexpr int RING_BYTES = 131072, LDS_BYTES = RING_BYTES + 2048;

#define LAS __attribute__((address_space(3)))
typedef unsigned short bf16;
#define RLX_AGENT __ATOMIC_RELAXED, __HIP_MEMORY_SCOPE_AGENT
#define XB_TMO      128
#define XB_XCNT(j)  (256  + 64 * (j))
#define XB_XSUB(j)  (1280 + 64 * (j))
#define XB_XGEN(j)  (2304 + 64 * (j))
#define XB_TOP      3328
#define XB_TOPGEN   3392
#define XCD_BAR_WORDS 3456
#define XB_SPIN_CAP (1u << 18)

__device__ __forceinline__ unsigned xb_ld(unsigned* p)              { return __hip_atomic_load(p, __ATOMIC_RELAXED, __HIP_MEMORY_SCOPE_AGENT); }
__device__ __forceinline__ unsigned xb_add(unsigned* p, unsigned v) { return __hip_atomic_fetch_add(p, v, __ATOMIC_RELAXED, __HIP_MEMORY_SCOPE_AGENT); }
__device__ __forceinline__ unsigned xb_xcc_id() { return (unsigned)__builtin_amdgcn_s_getreg((3 << 11) | 20) & 0xFu; }
#define XB_SPIN(cond, bar) do { unsigned _sp = 0; while (cond) { __builtin_amdgcn_s_sleep(1); \
    if ((++_sp & 255u) == 0u) { if (xb_ld(&(bar)[XB_TMO])) break; if (_sp > XB_SPIN_CAP) { atomicAdd(&(bar)[XB_TMO], 1u); break; } } } } while (0)

struct XcdBarrier {
    unsigned* bar; unsigned x;
    volatile LAS unsigned* st;
};

__device__ __forceinline__ XcdBarrier xcd_barrier_post(unsigned* bar, volatile LAS unsigned* st) {
    XcdBarrier b; b.bar = bar; b.x = xb_xcc_id(); b.st = st;
    if (threadIdx.x == 0) (void)xb_add(&bar[XB_XCNT(b.x)], 1u);
    return b;
}
__device__ __forceinline__ void xcd_barrier_complete(unsigned* bar, unsigned x, unsigned& nloc, unsigned& nx) {
    const unsigned G = gridDim.x * gridDim.y * gridDim.z;
    unsigned sum, cnt, mine, sp = 0u;
    for (;;) {
        sum = 0u; cnt = 0u; mine = 0u;
#pragma unroll
        for (unsigned j = 0; j < 16; ++j) { const unsigned c = xb_ld(&bar[XB_XCNT(j)]); sum += c; cnt += (c > 0u) ? 1u : 0u; mine = (j == x) ? c : mine; }
        if (sum == G) break;
        __builtin_amdgcn_s_sleep(1);
        if ((++sp & 255u) == 0u) { if (xb_ld(&bar[XB_TMO])) break; if (sp > XB_SPIN_CAP) { atomicAdd(&bar[XB_TMO], 1u); break; } }
    }
    nloc = mine > 0u ? mine : 1u; nx = cnt > 0u ? cnt : 1u;
}

__device__ __forceinline__ void xcd_barrier(const XcdBarrier& b) {
    asm volatile("s_waitcnt vmcnt(0)" ::: "memory");
    __syncthreads();
    if (threadIdx.x == 0) {
        unsigned* bar = b.bar;
        __builtin_amdgcn_s_waitcnt(0);
        unsigned nloc = b.st[0], nx = b.st[1];
        if (nloc == 0u) { xcd_barrier_complete(bar, b.x, nloc, nx); b.st[0] = nloc; b.st[1] = nx; }
        const unsigned old = xb_add(&bar[XB_XSUB(b.x)], 1u);
        const unsigned gen = old / nloc;
        if (old + 1u == (gen + 1u) * nloc) {
            __builtin_amdgcn_fence(__ATOMIC_RELEASE, "agent");
            asm volatile("s_waitcnt vmcnt(0)" ::: "memory");
            const unsigned og = xb_add(&bar[XB_TOP], 1u);
            const unsigned tg = og / nx;
            if (og + 1u == (tg + 1u) * nx) xb_add(&bar[XB_TOPGEN], 1u);
            else XB_SPIN(xb_ld(&bar[XB_TOPGEN]) == tg, bar);
            __builtin_amdgcn_fence(__ATOMIC_ACQUIRE, "agent");
            xb_add(&bar[XB_XGEN(b.x)], 1u);
            asm volatile("s_waitcnt vmcnt(0)" ::: "memory");
        } else {
            XB_SPIN(xb_ld(&bar[XB_XGEN(b.x)]) == gen, bar);
            __builtin_amdgcn_fence(__ATOMIC_ACQUIRE, "agent");
            asm volatile("s_waitcnt vmcnt(0)" ::: "memory");
        }
    }
    __syncthreads();
}

constexpr size_t WS_CNT = 1 * MiB + 65536;
constexpr size_t WS_BAR = 1 * MiB;
typedef unsigned v4u __attribute__((ext_vector_type(4)));
typedef float f32x4 __attribute__((ext_vector_type(4)));
__device__ __forceinline__ unsigned pk2(float lo, float hi) { return pg8::cvt_pk_bf16(lo, hi); }
__device__ __forceinline__ float wave_sum(float v) {
#pragma unroll
    for (int o = 1; o < 64; o <<= 1) v += __shfl_xor(v, o);
    return v;
}
__device__ __forceinline__ int src_col(int mode, int n) {
    if (mode == 1) { if (n < 2048) { const int i = n & 63; return (n & ~63) + ((i & 1) << 5) + (i >> 1); } return n; }
    if (mode == 2) { if (n >= 256) { const int i = n - 256; return 256 + ((i & 1) << 5) + (i >> 1); } return n; }
    if (mode == 3) { const int hd = n / 192, i = n - hd * 192; if (i >= 128) { const int j = i - 128; return hd * 192 + 128 + ((j & 1) << 5) + (j >> 1); } return n; }
    return n;
}
__device__ __forceinline__ void conv_item(const float* W, int K, int N, const float* gain, bf16* WT, int row_off, int mode, LAS float* scr, int item, int lane) {
    const int nblk = N / 32, kb = item / nblk, nb = item % nblk, k0 = 64 * kb, n0 = 32 * nb;
    const int sc_ = src_col(mode, n0 + (lane & 31));
#pragma unroll 16
    for (int i = 0; i < 32; ++i) { const int kk = 2 * i + (lane >> 5); float w = W[(size_t)(k0 + kk) * N + sc_]; if (gain) w *= gain[k0 + kk]; scr[kk * 33 + (lane & 31)] = w; }
    asm volatile("s_waitcnt lgkmcnt(0)" ::: "memory");
    const int c = lane & 7;
#pragma unroll
    for (int j = 0; j < 4; ++j) { const int n = (lane >> 3) + 8 * j; const LAS float* s = scr + (8 * c) * 33 + n;
        v4u o; o.x = pk2(s[0 * 33], s[1 * 33]); o.y = pk2(s[2 * 33], s[3 * 33]); o.z = pk2(s[4 * 33], s[5 * 33]); o.w = pk2(s[6 * 33], s[7 * 33]);
        *(v4u*)(WT + (size_t)(row_off + n0 + n) * K + k0 + 8 * c) = o; }
    asm volatile("s_waitcnt lgkmcnt(0)" ::: "memory");
}
__device__ __forceinline__ void conv_matrix(const float* W, int K, int N, const float* gain, bf16* WT, int row_off, int mode, LAS float* scr, int gw, int NGW, int lane) {
    const int nitems = (K / 64) * (N / 32);
    for (int it = gw; it < nitems; it += NGW) conv_item(W, K, N, gain, WT, row_off, mode, scr, it, lane);
}

struct Args { const float* in[21]; float* out; unsigned char* ws; float inv_freq[32]; int ph_lo, ph_hi; };

__global__ void __launch_bounds__(NWAVES * 64, 2) mk_fwd(Args args) {
    extern __shared__ __attribute__((aligned(16))) unsigned char lds[];
    cg::grid_group grid = cg::this_grid();
    const int tid = threadIdx.x, lane = tid & 63, wave = __builtin_amdgcn_readfirstlane(tid >> 6);
    const int G = gridDim.x, bx = blockIdx.x;
    const int vcu = (G % 8 == 0) ? (bx % 8) * (G / 8) + bx / 8 : bx;
    unsigned char* ws = args.ws;
    const float* x = args.in[0]; float* out = args.out;
    bf16* Wqkv = (bf16*)(ws + WS_WQKV); bf16* Woa = (bf16*)(ws + WS_WOA); bf16* Wup0 = (bf16*)(ws + WS_WUP0); bf16* Wdn0 = (bf16*)(ws + WS_WDN0);
    bf16* Wdkvq = (bf16*)(ws + WS_WDKVQ); bf16* Wukv = (bf16*)(ws + WS_WUKV); bf16* Wuq = (bf16*)(ws + WS_WUQ); bf16* Wob = (bf16*)(ws + WS_WOB);
    bf16* Wup1 = (bf16*)(ws + WS_WUP1); bf16* Wdn1 = (bf16*)(ws + WS_WDN1);
    float* COS = (float*)(ws + WS_COS); float* SIN = (float*)(ws + WS_SIN);
    float* SSQ = (float*)(ws + WS_SSQ);
    bf16* HB = (bf16*)(ws + WS_HB); bf16* QKV = (bf16*)(ws + WS_R1); bf16* U = (bf16*)(ws + WS_R1);
    bf16* KVb = (bf16*)(ws + WS_KV); bf16* QB = (bf16*)(ws + WS_QB); bf16* CB = (bf16*)(ws + WS_CB); bf16* KR = (bf16*)(ws + WS_KR);
    bf16* OB = (bf16*)(ws + WS_O); bf16* CQ = (bf16*)(ws + WS_CQ);
    const int lo = args.ph_lo, hi_ = args.ph_hi;
#ifndef PHMASK
#define PHMASK 0x1fff
#endif
#define IN(k) ((((PHMASK) >> (k)) & 1) && lo <= (k) && (k) < hi_)
#ifndef DUPMASK
#define DUPMASK 0
#endif
#define NREP(k) (1 + (((DUPMASK) >> (k)) & 1))
#ifndef SYNCDUP
#define SYNCDUP 1
#endif
#define SEAM(k) do { if (IN(k) && IN((k) + 1)) { for (int s_ = 0; s_ < SYNCDUP; ++s_) { xcd_barrier(bar); } } } while (0)
    LAS unsigned char* lds3 = (LAS unsigned char*)lds;
    volatile LAS unsigned* MISC = (volatile LAS unsigned*)(lds3 + RING_BYTES + 1024);
    if (tid < 2) MISC[tid] = 0u;
    __syncthreads();
    XcdBarrier bar; bar.bar = (unsigned*)(ws + WS_BAR); bar.x = 0; bar.st = MISC;
    if (args.ph_hi - args.ph_lo > 1) bar = xcd_barrier_post((unsigned*)(ws + WS_BAR), MISC);
    if (args.ph_lo > 4096) grid.sync();
    constexpr float LOG2E = 1.4426950408889634f;

    for (int rep0_ = 0; rep0_ < NREP(0); ++rep0_) if (IN(0)) {
        LAS float* scr = (LAS float*)(lds3 + wave * 16384);
        const int gw = vcu * NWAVES + wave, NGW = G * NWAVES;
        {
            constexpr int I0 = (DM / 64) * (NQKV / 32), I1 = I0 + (DM / 64) * (DM / 32), I2 = I1 + (DM / 64) * (FF / 32), I3 = I2 + (FF / 64) * (DM / 32),
                          I4 = I3 + (DM / 64) * (320 / 32), I5 = I4 + (DM / 64) * (QL / 32), I6 = I5 + (KVL / 64) * (NUKV / 32), I7 = I6 + (QL / 64) * (NUQ / 32),
                          I8 = I7 + (DM / 64) * (DM / 32), I9 = I8 + (DM / 64) * (FF / 32), I10 = I9 + (FF / 64) * (DM / 32);
            for (int it = gw; it < I10; it += NGW) {
                if (it < I0) conv_item(args.in[2], DM, NQKV, args.in[1], Wqkv, 0, 1, scr, it, lane);
                else if (it < I1) conv_item(args.in[8], DM, DM, nullptr, Woa, 0, 0, scr, it - I0, lane);
                else if (it < I2) conv_item(args.in[18], DM, FF, args.in[17], Wup0, 0, 0, scr, it - I1, lane);
                else if (it < I3) conv_item(args.in[19], FF, DM, nullptr, Wdn0, 0, 0, scr, it - I2, lane);
                else if (it < I4) conv_item(args.in[10], DM, 320, args.in[9], Wdkvq, 0, 2, scr, it - I3, lane);
                else if (it < I5) conv_item(args.in[13], DM, QL, args.in[1] + DM, Wdkvq, 320, 0, scr, it - I4, lane);
                else if (it < I6) conv_item(args.in[12], KVL, NUKV, args.in[11], Wukv, 0, 0, scr, it - I5, lane);
                else if (it < I7) conv_item(args.in[15], QL, NUQ, args.in[14], Wuq, 0, 3, scr, it - I6, lane);
                else if (it < I8) conv_item(args.in[16], DM, DM, nullptr, Wob, 0, 0, scr, it - I7, lane);
                else if (it < I9) conv_item(args.in[18] + (size_t)DM * FF, DM, FF, args.in[17] + DM, Wup1, 0, 0, scr, it - I8, lane);
                else conv_item(args.in[19] + (size_t)FF * DM, FF, DM, nullptr, Wdn1, 0, 0, scr, it - I9, lane);
            }
        }
        const int gt = bx * (NWAVES * 64) + tid, NGT = G * NWAVES * 64;
        for (int i = gt; i < 64 * DM / 8; i += NGT) ((v4u*)(Wdkvq + (size_t)704 * DM))[i] = (v4u){0u, 0u, 0u, 0u};
        for (int i = gt; i < SEQ * 32; i += NGT) {
            const int pos = i >> 5, j = i & 31; const float ang = (float)pos * args.inv_freq[j];
            double rev = (double)ang * 0.15915494309189535; rev -= floor(rev); const float fr = (float)rev;
            COS[i] = __builtin_amdgcn_cosf(fr); SIN[i] = __builtin_amdgcn_sinf(fr); }
        for (int i = gt; i < 6 * M; i += NGT) SSQ[M + i] = 0.f;
        for (int m = gw; m < M; m += 2 * NGW) {
            const int m2 = m + NGW;
            const bool has2 = m2 < M;
            const f32x4* xr = (const f32x4*)(x + (size_t)m * DM) + lane; const f32x4* xr2 = (const f32x4*)(x + (size_t)(has2 ? m2 : m) * DM) + lane;
            f32x4 v[4], w[4]; float s = 0.f, s2 = 0.f;
#pragma unroll
            for (int j = 0; j < 4; ++j) { v[j] = xr[64 * j]; w[j] = xr2[64 * j]; }
#pragma unroll
            for (int j = 0; j < 4; ++j) { s += (v[j].x * v[j].x + v[j].y * v[j].y) + (v[j].z * v[j].z + v[j].w * v[j].w); s2 += (w[j].x * w[j].x + w[j].y * w[j].y) + (w[j].z * w[j].z + w[j].w * w[j].w); }
            s = wave_sum(s); s2 = wave_sum(s2);
            if (lane == 0) { SSQ[m] = s; if (has2) SSQ[m2] = s2; }
            unsigned long long* o8 = (unsigned long long*)(HB + (size_t)m * DM) + lane; unsigned long long* o82 = (unsigned long long*)(HB + (size_t)(has2 ? m2 : m) * DM) + lane;
#pragma unroll
            for (int j = 0; j < 4; ++j) { o8[64 * j] = (unsigned long long)pk2(v[j].x, v[j].y) | ((unsigned long long)pk2(v[j].z, v[j].w) << 32);
                if (has2) o82[64 * j] = (unsigned long long)pk2(w[j].x, w[j].y) | ((unsigned long long)pk2(w[j].z, w[j].w) << 32); }
        }
    }
    SEAM(0);
    if (IN(1)) {
        pg8::Gemm g{HB, Wqkv, M, NQKV, DM}; pg8::StaticOrder S; S.init(M, NQKV, G, bx); S.rep = NREP(1);
        pg8::EpiQKV E{QKV, SSQ, COS, SIN, 0.125f * LOG2E};
        pg8::gemm_phase<pg8::EpiQKV, pg8::StaticOrder, true, true>(lds3, g, S, E);
    }
    SEAM(1);
    if (IN(2)) {
        const float a1 = wave_sum(args.in[3][lane] * args.in[4][lane]), a2 = wave_sum(args.in[5][lane] * args.in[6][lane]);
        const float lam = __expf(a1) - __expf(a2) + 0.2f;
        for (int slot = vcu; slot < 256; slot += G) {
            const int xcd = slot >> 5, i = slot & 31;
            for (int r_ = 0; r_ < 8 * NREP(2); ++r_) { const int r = r_ & 7;
                const int bh = 8 * xcd + r, qb = (r & 1) ? i : 31 - i, b = bh >> 3, h = bh & 7;
                const bf16* base = QKV + (size_t)b * SEQ * NQKV;
                att::attn_unit<0>((char*)lds, lds3, base + h * 128, base + 1024 + h * 128, nullptr, base + 2048 + h * 128, OB + (size_t)b * SEQ * DM + h * 128, qb * 128, lam, args.in[7]);
            }
        }
    }
    SEAM(2);
    if (IN(3)) {
        pg8::Gemm g{OB, Woa, M, DM, DM}; pg8::StaticOrder S; S.init(M, DM, G, bx);
        pg8::EpiRes E{HB, SSQ + M};
        pg8::gemm_phase<pg8::EpiRes, pg8::StaticOrder, true, true>(lds3, g, S, E);
    }
    SEAM(3);
    if (IN(4)) {
        pg8::Gemm g{HB, Wup0, M, FF, DM}; pg8::StaticOrder S; S.init(M, FF, G, bx); S.rep = NREP(4);
        pg8::EpiUp E{U, SSQ + M};
        pg8::gemm_phase<pg8::EpiUp, pg8::StaticOrder, true, true>(lds3, g, S, E);
    }
    SEAM(4);
    if (IN(5)) {
        pg8::Gemm g{U, Wdn0, M, DM, FF}; pg8::StaticOrder S; S.init(M, DM, G, bx);
        pg8::EpiRes E{HB, SSQ + 2 * M};
        pg8::gemm_phase<pg8::EpiRes, pg8::StaticOrder, true, true>(lds3, g, S, E);
    }
    SEAM(5);
    if (IN(6)) {
        pg8::Gemm g{HB, Wdkvq, M, NDKVQ, DM}; pg8::StaticOrder S; S.init(M, NDKVQ, G, bx);
        pg8::EpiDkvq E{CB, KR, CQ, SSQ + 2 * M, SSQ + 5 * M, SSQ + 6 * M, COS, SIN};
        pg8::gemm_phase<pg8::EpiDkvq, pg8::StaticOrder, true, true>(lds3, g, S, E);
    }
    SEAM(6);
    if (IN(7)) {
        { pg8::Gemm g{CB, Wukv, M, NUKV, KVL}; pg8::StaticOrder S; S.init(M, NUKV, G, bx); S.rep = NREP(7);
          pg8::EpiLat<false, NUKV> E{KVb, SSQ + 5 * M, 1.0f / 256.0f, 1.0f, COS, SIN};
          pg8::gemm_phase<pg8::EpiLat<false, NUKV>, pg8::StaticOrder, true, true>(lds3, g, S, E); }
        { pg8::Gemm g{CQ, Wuq, M, NUQ, QL}; pg8::StaticOrder S; S.init(M, NUQ, G, bx); S.rep = NREP(7);
          pg8::EpiLat<true, NUQ> E{QB, SSQ + 6 * M, 1.0f / 384.0f, 0.07216878364870322f * LOG2E, COS, SIN};
          pg8::gemm_phase<pg8::EpiLat<true, NUQ>, pg8::StaticOrder, true, true>(lds3, g, S, E); }
    }
    SEAM(7);
    if (IN(8)) {
        for (int slot = vcu; slot < 256; slot += G) {
            const int xcd = slot >> 5, i = slot & 31, j = i & 15, gsel = i >> 4;
            for (int r_ = 0; r_ < 4 * NREP(8); ++r_) { const int r = r_ & 3;
                const int bh = 8 * xcd + 4 * (r >> 1) + 2 * gsel + (r & 1), qb = (r & 1) ? j : 15 - j, b = bh >> 3, h = bh & 7;
                att::attn_unit<1>((char*)lds, lds3, QB + (size_t)b * SEQ * NUQ + h * 192, KVb + (size_t)b * SEQ * NUKV + h * 256, KR + (size_t)b * SEQ * 64,
                                  KVb + (size_t)b * SEQ * NUKV + h * 256 + 128, OB + (size_t)b * SEQ * DM + h * 128, qb * 256, 0.f, nullptr);
            }
        }
    }
    SEAM(8);
    if (IN(9)) {
        pg8::Gemm g{OB, Wob, M, DM, DM}; pg8::StaticOrder S; S.init(M, DM, G, bx);
        pg8::EpiRes E{HB, SSQ + 3 * M};
        pg8::gemm_phase<pg8::EpiRes, pg8::StaticOrder, true, true>(lds3, g, S, E);
    }
    SEAM(9);
    if (IN(10)) {
        pg8::Gemm g{HB, Wup1, M, FF, DM}; pg8::StaticOrder S; S.init(M, FF, G, bx); S.rep = NREP(10);
        pg8::EpiUp E{U, SSQ + 3 * M};
        pg8::gemm_phase<pg8::EpiUp, pg8::StaticOrder, true, true>(lds3, g, S, E);
    }
    SEAM(10);
    if (IN(11)) {
        pg8::Gemm g{U, Wdn1, M, DM, FF}; pg8::StaticOrder S; S.init(M, DM, G, bx);
        pg8::EpiResFinal E{HB, SSQ + 4 * M, (unsigned*)(ws + WS_CNT), out, args.in[20]};
        pg8::gemm_phase<pg8::EpiResFinal, pg8::StaticOrder, true, true>(lds3, g, S, E);
    }
    if (false) {
        const int gw = vcu * NWAVES + wave, NGW = G * NWAVES; const float* fg = args.in[20];
        f32x4 gv[4];
#pragma unroll
        for (int j = 0; j < 2; ++j) { gv[2 * j] = ((const f32x4*)fg)[128 * j + 2 * lane]; gv[2 * j + 1] = ((const f32x4*)fg)[128 * j + 2 * lane + 1]; }
        for (int m = gw; m < M; m += NGW) {
            const float rs = rsqrtf(SSQ[4 * M + m] * (1.0f / 1024.0f) + 1e-6f);
            const v4u* hr = (const v4u*)(HB + (size_t)m * DM); f32x4* orow = (f32x4*)(out + (size_t)m * DM);
#pragma unroll
            for (int j = 0; j < 2; ++j) { const v4u w = hr[64 * j + lane];
                const f32x4 a = (f32x4){__uint_as_float(w.x << 16), __uint_as_float(w.x & 0xffff0000u), __uint_as_float(w.y << 16), __uint_as_float(w.y & 0xffff0000u)};
                const f32x4 b = (f32x4){__uint_as_float(w.z << 16), __uint_as_float(w.z & 0xffff0000u), __uint_as_float(w.w << 16), __uint_as_float(w.w & 0xffff0000u)};
                orow[128 * j + 2 * lane] = a * rs * gv[2 * j]; orow[128 * j + 2 * lane + 1] = b * rs * gv[2 * j + 1]; }
        }
    }
#undef IN
#undef SEAM
}

extern "C" void kernel_launch(void* const* d_in, const int* in_sizes, int n_in, void* d_out, int out_size, void* d_ws, size_t ws_size, hipStream_t stream) {
    static int grid = 0;
    if (grid == 0) {
        if (n_in != 21 || in_sizes[0] != M * DM || out_size != M * DM || ws_size < WS_END) {
            fprintf(stderr, "kernel_launch: unexpected shapes (n_in %d, in0 %d, out %d, ws %zu); nothing launched\n", n_in, n_in > 0 ? in_sizes[0] : -1, out_size, ws_size); grid = -1; return; }
        int dev = 0, cus = 0, per_cu = 0;
        (void)hipGetDevice(&dev); (void)hipDeviceGetAttribute(&cus, hipDeviceAttributeMultiprocessorCount, dev);
        if (hipFuncSetAttribute((const void*)mk_fwd, hipFuncAttributeMaxDynamicSharedMemorySize, LDS_BYTES) != hipSuccess) { fprintf(stderr, "kernel_launch: hipFuncSetAttribute failed\n"); grid = -1; return; }
        if (hipOccupancyMaxActiveBlocksPerMultiprocessor(&per_cu, (const void*)mk_fwd, NWAVES * 64, LDS_BYTES) != hipSuccess || per_cu < 1) { fprintf(stderr, "kernel_launch: occupancy query says %d\n", per_cu); per_cu = 1; }
        (void)hipGetLastError();
        if (cus <= 0) cus = 256;
        grid = cus * 1;
    }
    if (grid < 0) return;
    Args a{};
    for (int i = 0; i < 21; ++i) a.in[i] = (const float*)d_in[i];
    a.out = (float*)d_out; a.ws = (unsigned char*)d_ws;
    for (int j = 0; j < 32; ++j) a.inv_freq[j] = powf(10000.0f, -((float)(2 * j)) / 64.0f);
#if MK_SINGLE
    a.ph_lo = 0; a.ph_hi = NPHASE;
    if (hipMemsetAsync((char*)d_ws + WS_BAR, 0, 65536 + 128 * 256, stream) != hipSuccess) { fprintf(stderr, "kernel_launch: hipMemsetAsync failed\n"); return; }
    void* kargs[] = {&a};
    hipError_t e = hipLaunchCooperativeKernel((const void*)mk_fwd, dim3(grid), dim3(NWAVES * 64), kargs, LDS_BYTES, stream);
    if (e != hipSuccess) fprintf(stderr, "kernel_launch: cooperative launch failed: %s (grid %d)\n", hipGetErrorString(e), grid);
#else
    for (int p = 0; p < NPHASE; ++p) { a.ph_lo = p; a.ph_hi = p + 1; hipLaunchKernelGGL(mk_fwd, dim3(grid), dim3(NWAVES * 64), LDS_BYTES, stream, a); }
#endif
}
```

```cpp
#include <hip/hip_runtime.h>
#include <hip/hip_cooperative_groups.h>
#include <cstdio>
#include <cstdint>
#include <cmath>
namespace cg = cooperative_groups;
#define MK_SINGLE 1
namespace pg8 {
#define PG8_LAS __attribute__((address_space(3)))
typedef unsigned short bf16_t;
typedef short bf16x8 __attribute__((ext_vector_type(8)));
typedef float f32x4 __attribute__((ext_vector_type(4)));
typedef unsigned u32x4 __attribute__((ext_vector_type(4)));
constexpr int BM = 256, BK = 64, HALF = 128, HTB = HALF * BK * 2  , STAGE_BYTES = 8 * HTB, NXCD = 8, WGM = 4;

__host__ __device__ __forceinline__ int lds_byte(int r, int c) { const int st = (r >> 4) * 2 + (c >> 5), rr = r & 15, cc = c & 31, ob = rr * 64 + cc * 2; return st * 1024 + (ob ^ (((ob >> 9) & 1) << 5)); }
__host__ __device__ __forceinline__ void stage_rc(int b, int& R, int& C) { const int st = b / 1024, sb = b % 1024, swz = sb ^ (((sb >> 9) & 1) << 5); R = (st >> 1) * 16 + swz / 64; C = (st & 1) * 32 + (swz % 64) / 2; }
__host__ __device__ __forceinline__ int perm32(int rho) { const int n = rho >> 4, i = rho & 15; return 8 * (i >> 2) + 4 * n + (i & 3); }

struct Unit { int pm, pn; };
struct Gemm { const bf16_t* A; const bf16_t* Bt; int M, N, K; };

struct StaticOrder {
    int nM, nN, nwg, G, c, rep = 1;
    __host__ __device__ void init(int M, int N, int G_, int c_) { nM = M / BM; nN = N / BM; nwg = nM * nN; G = G_; c = c_; }
    __host__ __device__ bool next(int i, Unit& u) const {
        const long L = (long)i * G + c; if (L >= (long)nwg * rep) return false;
        int wgid = (int)(L >= nwg ? L - nwg : L); { const int q = nwg / NXCD, r = nwg % NXCD, xcd = wgid % NXCD, off = wgid / NXCD; wgid = (xcd < r ? xcd * (q + 1) : r * (q + 1) + (xcd - r) * q) + off; }
        const int nig = WGM * nN, gid = wgid / nig, fm = gid * WGM, gsz = (nM - fm) < WGM ? (nM - fm) : WGM;
        u.pm = fm + ((wgid % nig) % gsz); u.pn = (wgid % nig) / gsz; return true;
    }
    __device__ __forceinline__ void a_ready(const Unit&) const {}
    __device__ __forceinline__ void done(const Unit&) const {}
};

__device__ __forceinline__ unsigned cvt_pk_bf16(float lo, float hi) { unsigned r; asm volatile("v_cvt_pk_bf16_f32 %0, %1, %2" : "=v"(r) : "v"(lo), "v"(hi)); return r; }

template <class Epi, class Sched, bool ALIGN_EPI = false, bool SP2 = false>
__device__ __forceinline__ void gemm_phase(PG8_LAS unsigned char* lds, const Gemm g, const Sched& S, const Epi& E) {
    const int tid = threadIdx.x, wid = __builtin_amdgcn_readfirstlane(tid >> 6), lane = tid & 63, wr = wid >> 2, wc = wid & 3, fr = lane & 15, fq = lane >> 4;
    const int K = g.K, nt = K / BK;
    unsigned voffA[2], voffB[2];
#pragma unroll
    for (int i = 0; i < 2; ++i) { int R, C; stage_rc(tid * 16 + i * 8192, R, C); const int Rb = Epi::PERM ? ((R & ~31) + perm32(R & 31)) : R;
        voffA[i] = (unsigned)(R * K + C) * 2u; voffB[i] = (unsigned)(Rb * K + C) * 2u; }
    const size_t kstep = (size_t)(BK * 2);
    const size_t hstep = (size_t)HALF * K * 2;
    const size_t tstep = 2 * hstep;
    const unsigned ldsw = (unsigned)wid * 1024u;
    const int aoff = lds_byte(wr * 64 + fr, fq * 8), boff = lds_byte(wc * 32 + fr, fq * 8);
#define PG8_SA(b, h) (((b) * 2 + (h)) * HTB)
#define PG8_SB(b, h) ((4 + (b) * 2 + (h)) * HTB)
#define PG8_STAGE(bufoff, gbase, voff) do { _Pragma("unroll") for (int _i = 0; _i < 2; ++_i) \
        __builtin_amdgcn_global_load_lds((const unsigned*)((const char*)(gbase) + (voff)[_i]), (PG8_LAS unsigned*)(lds + (bufoff) + ldsw + _i * 8192), 16, 0, 0); } while (0)
#define PG8_LDA(dst, b, h) do { _Pragma("unroll") for (int m = 0; m < 4; ++m) _Pragma("unroll") for (int k = 0; k < 2; ++k) dst[m][k] = *(const PG8_LAS bf16x8*)(lds + PG8_SA(b, h) + aoff + m * 2048 + k * 1024); } while (0)
#define PG8_LDB(dst, b, h) do { _Pragma("unroll") for (int n = 0; n < 2; ++n) _Pragma("unroll") for (int k = 0; k < 2; ++k) dst[n][k] = *(const PG8_LAS bf16x8*)(lds + PG8_SB(b, h) + boff + n * 2048 + k * 1024); } while (0)
#define PG8_MMA(ai, bj, At, Bt) do { __builtin_amdgcn_s_setprio(1); _Pragma("unroll") for (int m = 0; m < 4; ++m) _Pragma("unroll") for (int n = 0; n < 2; ++n) _Pragma("unroll") for (int k = 0; k < 2; ++k) \
        acc[ai][bj][m][n] = __builtin_amdgcn_mfma_f32_16x16x32_bf16(Bt[n][k], At[m][k], acc[ai][bj][m][n], 0, 0, 0); __builtin_amdgcn_s_setprio(0); } while (0)
#define PG8_WAIT_V(n) asm volatile("s_waitcnt vmcnt(" #n ")" ::: "memory")
#define PG8_WAIT_L(n) asm volatile("s_waitcnt lgkmcnt(" #n ")" ::: "memory")
#define PG8_BAR __builtin_amdgcn_s_barrier()
#define PG8_SCHED __builtin_amdgcn_sched_barrier(0)
    Unit cur, nxt; int ui = 0;
    if (!S.next(0, cur)) return;
    f32x4 acc[2][2][4][2];
#pragma unroll
    for (int a = 0; a < 2; ++a)
#pragma unroll
        for (int b = 0; b < 2; ++b)
#pragma unroll
            for (int m = 0; m < 4; ++m)
#pragma unroll
                for (int n = 0; n < 2; ++n) acc[a][b][m][n] = (f32x4){0.f, 0.f, 0.f, 0.f};
    bf16x8 At[4][2], B0[2][2], B1[2][2];
    const char* cA = (const char*)g.A + (size_t)cur.pm * tstep; const char* cB = (const char*)g.Bt + (size_t)cur.pn * tstep;
    S.a_ready(cur);
    if constexpr (SP2) {
        PG8_STAGE(PG8_SB(0, 0), cB, voffB); PG8_STAGE(PG8_SB(0, 1), cB + hstep, voffB); PG8_STAGE(PG8_SA(0, 0), cA, voffA); PG8_STAGE(PG8_SA(0, 1), cA + hstep, voffA);
        if (wr == 1) PG8_BAR;
        PG8_WAIT_V(2); PG8_BAR;
        PG8_STAGE(PG8_SB(1, 0), cB + kstep, voffB); PG8_STAGE(PG8_SA(1, 0), cA + kstep, voffA); PG8_STAGE(PG8_SB(1, 1), cB + hstep + kstep, voffB);
        PG8_WAIT_V(6); PG8_BAR;
    } else {
        PG8_STAGE(PG8_SB(0, 0), cB, voffB); PG8_STAGE(PG8_SA(0, 0), cA, voffA); PG8_STAGE(PG8_SB(0, 1), cB + hstep, voffB); PG8_STAGE(PG8_SA(0, 1), cA + hstep, voffA);
        if (wr == 1) PG8_BAR;
        PG8_WAIT_V(4); PG8_BAR;
        PG8_STAGE(PG8_SB(1, 0), cB + kstep, voffB); PG8_STAGE(PG8_SA(1, 0), cA + kstep, voffA); PG8_STAGE(PG8_SB(1, 1), cB + hstep + kstep, voffB);
        PG8_WAIT_V(6); PG8_BAR;
    }
    for (;;) {
        const bool has_next = S.next(ui + 1, nxt);
        const char* nA = has_next ? (const char*)g.A + (size_t)nxt.pm * tstep : cA; const char* nB = has_next ? (const char*)g.Bt + (size_t)nxt.pn * tstep : cB;
#pragma unroll 1
        for (int t = 0; t < nt; t += 2) {
            const bool last = (t == nt - 2);
            const char* a1 = cA + (size_t)(t + 1) * kstep;
            const char* a2 = last ? nA : cA + (size_t)(t + 2) * kstep; const char* b2 = last ? nB : cB + (size_t)(t + 2) * kstep;
            const char* a3 = a2 + kstep; const char* b3 = b2 + kstep;
            if (last && has_next) S.a_ready(nxt);
            if constexpr (SP2) {
            PG8_LDB(B0, 0, 0); PG8_LDB(B1, 0, 1); PG8_SCHED; PG8_LDA(At, 0, 0); PG8_STAGE(PG8_SA(1, 1), a1 + hstep, voffA);
            PG8_WAIT_V(8); PG8_WAIT_L(0); PG8_BAR; PG8_MMA(0, 0, At, B0); PG8_MMA(0, 1, At, B1); PG8_BAR; PG8_SCHED;
            PG8_LDA(At, 0, 1); PG8_STAGE(PG8_SB(0, 0), b2, voffB); PG8_STAGE(PG8_SB(0, 1), b2 + hstep, voffB); PG8_STAGE(PG8_SA(0, 0), a2, voffA);
            PG8_WAIT_V(8); PG8_WAIT_L(0); PG8_BAR; PG8_MMA(1, 0, At, B0); PG8_MMA(1, 1, At, B1); PG8_BAR; PG8_SCHED;
            PG8_LDB(B0, 1, 0); PG8_LDB(B1, 1, 1); PG8_SCHED; PG8_LDA(At, 1, 0); PG8_STAGE(PG8_SA(0, 1), a2 + hstep, voffA);
            PG8_WAIT_V(8); PG8_WAIT_L(0); PG8_BAR; PG8_MMA(0, 0, At, B0); PG8_MMA(0, 1, At, B1); PG8_BAR; PG8_SCHED;
            PG8_LDA(At, 1, 1); PG8_STAGE(PG8_SB(1, 0), b3, voffB); PG8_STAGE(PG8_SB(1, 1), b3 + hstep, voffB); PG8_STAGE(PG8_SA(1, 0), a3, voffA);
            PG8_WAIT_V(8); PG8_WAIT_L(0); PG8_BAR; PG8_MMA(1, 0, At, B0); PG8_MMA(1, 1, At, B1); PG8_BAR; PG8_SCHED;
            } else {
            PG8_LDB(B0, 0, 0); PG8_SCHED; PG8_LDA(At, 0, 0); PG8_STAGE(PG8_SA(1, 1), a1 + hstep, voffA);
            PG8_WAIT_L(8); PG8_BAR; PG8_WAIT_L(0); PG8_MMA(0, 0, At, B0); PG8_BAR; PG8_SCHED;
            PG8_LDB(B1, 0, 1); PG8_STAGE(PG8_SB(0, 0), b2, voffB);
            PG8_BAR; PG8_WAIT_L(0); PG8_MMA(0, 1, At, B1); PG8_BAR;
            PG8_LDA(At, 0, 1); PG8_STAGE(PG8_SA(0, 0), a2, voffA);
            PG8_BAR; PG8_WAIT_L(0); PG8_MMA(1, 0, At, B0); PG8_BAR; PG8_SCHED;
            PG8_STAGE(PG8_SB(0, 1), b2 + hstep, voffB);
            PG8_WAIT_V(6); PG8_BAR; PG8_MMA(1, 1, At, B1); PG8_BAR;
            PG8_LDB(B0, 1, 0); PG8_SCHED; PG8_LDA(At, 1, 0); PG8_STAGE(PG8_SA(0, 1), a2 + hstep, voffA);
            PG8_WAIT_L(8); PG8_BAR; PG8_WAIT_L(0); PG8_MMA(0, 0, At, B0); PG8_BAR; PG8_SCHED;
            PG8_LDB(B1, 1, 1); PG8_STAGE(PG8_SB(1, 0), b3, voffB);
            PG8_BAR; PG8_WAIT_L(0); PG8_MMA(0, 1, At, B1); PG8_BAR;
            PG8_LDA(At, 1, 1); PG8_STAGE(PG8_SA(1, 0), a3, voffA);
            PG8_BAR; PG8_WAIT_L(0); PG8_MMA(1, 0, At, B0); PG8_BAR; PG8_SCHED;
            PG8_STAGE(PG8_SB(1, 1), b3 + hstep, voffB);
            PG8_WAIT_V(6); PG8_BAR; PG8_MMA(1, 1, At, B1); PG8_BAR;
            }
        }
        if constexpr (ALIGN_EPI) { if (wr == 0) PG8_BAR; }
        if constexpr (!Epi::AFTER_DRAIN) { E(acc, cur, wr, wc, fr, fq); S.done(cur); }
        if (!has_next) break;
#pragma unroll
        for (int a = 0; a < 2; ++a)
#pragma unroll
            for (int b = 0; b < 2; ++b)
#pragma unroll
                for (int m = 0; m < 4; ++m)
#pragma unroll
                    for (int n = 0; n < 2; ++n) acc[a][b][m][n] = (f32x4){0.f, 0.f, 0.f, 0.f};
        cur = nxt; cA = nA; cB = nB; ++ui;
        if constexpr (ALIGN_EPI) { if (wr == 1) PG8_BAR; }
    }
    PG8_WAIT_V(0);
    if constexpr (!ALIGN_EPI) { if (wr == 0) PG8_BAR; }
    PG8_BAR;
    if constexpr (Epi::AFTER_DRAIN) { E.fused(acc, cur, wr, wc, fr, fq, lds, wid, lane); S.done(cur); }
#undef PG8_SA
#undef PG8_SB
#undef PG8_STAGE
#undef PG8_LDA
#undef PG8_LDB
#undef PG8_MMA
#undef PG8_WAIT_V
#undef PG8_WAIT_L
#undef PG8_BAR
#undef PG8_SCHED
}
}

namespace pg8 {
typedef unsigned u32x4 __attribute__((ext_vector_type(4)));
typedef float f32x2_t __attribute__((ext_vector_type(2))); typedef __bf16 bf16x2_t __attribute__((ext_vector_type(2)));
__device__ __forceinline__ unsigned cvtpk2(float lo, float hi) { f32x2_t v = {lo, hi}; bf16x2_t b = __builtin_convertvector(v, bf16x2_t); return __builtin_bit_cast(unsigned, b); }
__device__ __forceinline__ u32x4 pack8(f32x4 a, f32x4 b) { u32x4 w; w.x = cvtpk2(a[0], a[1]); w.y = cvtpk2(a[2], a[3]); w.z = cvtpk2(b[0], b[1]); w.w = cvtpk2(b[2], b[3]); return w; }
__device__ __forceinline__ void rope8(f32x4& v0, f32x4& v1, const f32x4 c4, const f32x4 s4) {
    const f32x4 a = (f32x4){v0[0], v0[2], v1[0], v1[2]}, b = (f32x4){v0[1], v0[3], v1[1], v1[3]};
    const f32x4 x = a * c4 - b * s4, y = b * c4 + a * s4;
    v0 = (f32x4){x[0], y[0], x[1], y[1]}; v1 = (f32x4){x[2], y[2], x[3], y[3]}; }
__device__ __forceinline__ float sq8(const f32x4 a, const f32x4 b) { return (a[0] * a[0] + a[1] * a[1]) + (a[2] * a[2] + a[3] * a[3]) + (b[0] * b[0] + b[1] * b[1]) + (b[2] * b[2] + b[3] * b[3]); }
#define EPI_FENCE() asm volatile("" ::: "memory")
__device__ __forceinline__ void load_rs(float (&rs)[2][4], const float* ssq, int row0, float inv_kd) {
    float t[2][4];
#pragma unroll
    for (int ai = 0; ai < 2; ++ai)
#pragma unroll
        for (int m = 0; m < 4; ++m) t[ai][m] = ssq[row0 + ai * HALF + m * 16];
#pragma unroll
    for (int ai = 0; ai < 2; ++ai)
#pragma unroll
        for (int m = 0; m < 4; ++m) rs[ai][m] = rsqrtf(t[ai][m] * inv_kd + 1e-6f);
}

struct EpiQKV {
    static constexpr bool PERM = true, AFTER_DRAIN = false;
    bf16_t* O; const float* ssq; const float* cs; const float* sn; float qscale;
    __device__ __forceinline__ void operator()(const f32x4 (&acc)[2][2][4][2], const Unit& u, int wr, int wc, int fr, int fq) const {
        const int row0 = u.pm * BM + wr * 64 + fr, colt = u.pn * BM, region = colt >> 10;
        const int col0 = colt + wc * 32 + 8 * fq, j0 = (wc & 1) * 16 + 4 * fq;
        float rs[2][4]; load_rs(rs, ssq, row0, 1.0f / 1024.0f);
        const float qs = region == 0 ? qscale : 1.f;
#pragma unroll
        for (int ai = 0; ai < 2; ++ai) {
            f32x4 c4[4], s4[4];
            if (region < 2) {
#pragma unroll
                for (int m = 0; m < 4; ++m) { const int pos = (row0 + ai * HALF + m * 16) & 4095; c4[m] = *(const f32x4*)(cs + pos * 32 + j0); s4[m] = *(const f32x4*)(sn + pos * 32 + j0); }
            }
#pragma unroll
            for (int m = 0; m < 4; ++m) {
                const int row = row0 + ai * HALF + m * 16; const float r = rs[ai][m] * qs;
                bf16_t* rowp = O + (size_t)row * 3072 + col0;
#pragma unroll
                for (int bj = 0; bj < 2; ++bj) { f32x4 v0 = acc[ai][bj][m][0] * r, v1 = acc[ai][bj][m][1] * r;
                    if (region < 2) rope8(v0, v1, c4[m], s4[m]);
                    *(u32x4*)(rowp + bj * HALF) = pack8(v0, v1); }
            }
            EPI_FENCE();
        }
    }
};
struct EpiRes {
    static constexpr bool PERM = true, AFTER_DRAIN = false;
    bf16_t* hb; float* ssq;
    __device__ __forceinline__ void operator()(const f32x4 (&acc)[2][2][4][2], const Unit& u, int wr, int wc, int fr, int fq) const {
        const int row0 = u.pm * BM + wr * 64 + fr, col0 = u.pn * BM + wc * 32 + 8 * fq;
#pragma unroll
        for (int ai = 0; ai < 2; ++ai) {
            u32x4 bw[4][2];
#pragma unroll
            for (int m = 0; m < 4; ++m)
#pragma unroll
                for (int bj = 0; bj < 2; ++bj) bw[m][bj] = *(const u32x4*)(hb + (size_t)(row0 + ai * HALF + m * 16) * 1024 + col0 + bj * HALF);
#pragma unroll
            for (int m = 0; m < 4; ++m) {
                const int row = row0 + ai * HALF + m * 16; const size_t off = (size_t)row * 1024 + col0; float s = 0.f;
#pragma unroll
                for (int bj = 0; bj < 2; ++bj) { const u32x4 w = bw[m][bj];
                    const f32x4 b0 = (f32x4){__uint_as_float(w.x << 16), __uint_as_float(w.x & 0xffff0000u), __uint_as_float(w.y << 16), __uint_as_float(w.y & 0xffff0000u)};
                    const f32x4 b1 = (f32x4){__uint_as_float(w.z << 16), __uint_as_float(w.z & 0xffff0000u), __uint_as_float(w.w << 16), __uint_as_float(w.w & 0xffff0000u)};
                    const f32x4 v0 = acc[ai][bj][m][0] + b0, v1 = acc[ai][bj][m][1] + b1;
                    *(u32x4*)(hb + off + bj * HALF) = pack8(v0, v1);
                    s += sq8(v0, v1); }
                s += __shfl_xor(s, 16); s += __shfl_xor(s, 32);
                if (fq == 0) atomicAdd(ssq + row, s);
            }
            EPI_FENCE();
        }
    }
};
struct EpiResFinal {
    static constexpr bool PERM = true, AFTER_DRAIN = false;
    const bf16_t* hb; float* ssq; unsigned* cnt; float* out; const float* g;
    __device__ __forceinline__ void operator()(f32x4 (&acc)[2][2][4][2], const Unit& u, int wr, int wc, int fr, int fq) const {
        const int row0 = u.pm * BM + wr * 64 + fr, col0 = u.pn * BM + wc * 32 + 8 * fq;
#pragma unroll
        for (int ai = 0; ai < 2; ++ai) {
            u32x4 bw[4][2];
#pragma unroll
            for (int m = 0; m < 4; ++m)
#pragma unroll
                for (int bj = 0; bj < 2; ++bj) bw[m][bj] = *(const u32x4*)(hb + (size_t)(row0 + ai * HALF + m * 16) * 1024 + col0 + bj * HALF);
#pragma unroll
            for (int m = 0; m < 4; ++m) {
                const int row = row0 + ai * HALF + m * 16; float s = 0.f;
#pragma unroll
                for (int bj = 0; bj < 2; ++bj) { const u32x4 w = bw[m][bj];
                    const f32x4 b0 = (f32x4){__uint_as_float(w.x << 16), __uint_as_float(w.x & 0xffff0000u), __uint_as_float(w.y << 16), __uint_as_float(w.y & 0xffff0000u)};
                    const f32x4 b1 = (f32x4){__uint_as_float(w.z << 16), __uint_as_float(w.z & 0xffff0000u), __uint_as_float(w.w << 16), __uint_as_float(w.w & 0xffff0000u)};
                    acc[ai][bj][m][0] += b0; acc[ai][bj][m][1] += b1;
                    s += sq8(acc[ai][bj][m][0], acc[ai][bj][m][1]); }
                s += __shfl_xor(s, 16); s += __shfl_xor(s, 32);
                if (fq == 0) __hip_atomic_fetch_add(ssq + row, s, __ATOMIC_RELAXED, __HIP_MEMORY_SCOPE_AGENT);
            }
            EPI_FENCE();
        }
        asm volatile("s_waitcnt vmcnt(0)" ::: "memory");
        unsigned* c = cnt + 64 * u.pm;
        if (fr == 0 && fq == 0) __hip_atomic_fetch_add(c, 1u, __ATOMIC_RELAXED, __HIP_MEMORY_SCOPE_AGENT);
        { unsigned spins = 0; while (__hip_atomic_load(c, __ATOMIC_RELAXED, __HIP_MEMORY_SCOPE_AGENT) < 32u && ++spins < (1u << 22)) __builtin_amdgcn_s_sleep(2); }
        asm volatile("" ::: "memory");
        float rs[2][4];
#pragma unroll
        for (int ai = 0; ai < 2; ++ai)
#pragma unroll
            for (int m = 0; m < 4; ++m) rs[ai][m] = rsqrtf(__hip_atomic_load(ssq + row0 + ai * HALF + m * 16, __ATOMIC_RELAXED, __HIP_MEMORY_SCOPE_AGENT) * (1.0f / 1024.0f) + 1e-6f);
        f32x4 gv[2][2];
#pragma unroll
        for (int bj = 0; bj < 2; ++bj) { gv[bj][0] = *(const f32x4*)(g + col0 + bj * HALF); gv[bj][1] = *(const f32x4*)(g + col0 + bj * HALF + 4); }
#pragma unroll
        for (int ai = 0; ai < 2; ++ai)
#pragma unroll
            for (int m = 0; m < 4; ++m) { float* rowp = out + (size_t)(row0 + ai * HALF + m * 16) * 1024 + col0; const float r = rs[ai][m];
#pragma unroll
                for (int bj = 0; bj < 2; ++bj) { *(f32x4*)(rowp + bj * HALF) = acc[ai][bj][m][0] * r * gv[bj][0]; *(f32x4*)(rowp + bj * HALF + 4) = acc[ai][bj][m][1] * r * gv[bj][1]; } }
    }
};
struct EpiUp {
    static constexpr bool PERM = true, AFTER_DRAIN = false;
    bf16_t* O; const float* ssq;
    __device__ __forceinline__ void operator()(const f32x4 (&acc)[2][2][4][2], const Unit& u, int wr, int wc, int fr, int fq) const {
        const int row0 = u.pm * BM + wr * 64 + fr, col0 = u.pn * BM + wc * 32 + 8 * fq;
        float rs[2][4]; load_rs(rs, ssq, row0, 1.0f / 1024.0f);
#pragma unroll
        for (int ai = 0; ai < 2; ++ai)
#pragma unroll
            for (int m = 0; m < 4; ++m) {
                const int row = row0 + ai * HALF + m * 16; const float r = rs[ai][m];
                bf16_t* rowp = O + (size_t)row * 4096 + col0;
#pragma unroll
                for (int bj = 0; bj < 2; ++bj) { f32x4 v0 = acc[ai][bj][m][0] * r, v1 = acc[ai][bj][m][1] * r;
#pragma unroll
                    for (int e = 0; e < 4; ++e) { const float a = fmaxf(v0[e], 0.f), b = fmaxf(v1[e], 0.f); v0[e] = a * a; v1[e] = b * b; }
                    *(u32x4*)(rowp + bj * HALF) = pack8(v0, v1); }
            }
    }
};
struct EpiDkvq {
    static constexpr bool PERM = true, AFTER_DRAIN = false;
    bf16_t* Cb; bf16_t* KR; bf16_t* CQ; const float* ssq; float* ssq_c; float* ssq_q; const float* cs; const float* sn;
    __device__ __forceinline__ void operator()(const f32x4 (&acc)[2][2][4][2], const Unit& u, int wr, int wc, int fr, int fq) const {
        const int row0 = u.pm * BM + wr * 64 + fr;
        float rs[2][4]; load_rs(rs, ssq, row0, 1.0f / 1024.0f);
#pragma unroll
        for (int bj = 0; bj < 2; ++bj) {
            const int g = u.pn * BM + bj * HALF + wc * 32;
            if (g >= 704) continue;
            const bool isrope = (g >= 256 && g < 320);
#pragma unroll
            for (int ai = 0; ai < 2; ++ai) {
                f32x4 c4[4], s4[4];
                if (isrope) { const int j0 = ((g - 256) >> 1) + 4 * fq;
#pragma unroll
                    for (int m = 0; m < 4; ++m) { const int pos = (row0 + ai * HALF + m * 16) & 4095; c4[m] = *(const f32x4*)(cs + pos * 32 + j0); s4[m] = *(const f32x4*)(sn + pos * 32 + j0); } }
#pragma unroll
                for (int m = 0; m < 4; ++m) {
                    const int row = row0 + ai * HALF + m * 16; const float r = rs[ai][m];
                    f32x4 v0 = acc[ai][bj][m][0] * r, v1 = acc[ai][bj][m][1] * r;
                    if (g < 256) {
                        *(u32x4*)(Cb + (size_t)row * 256 + g + 8 * fq) = pack8(v0, v1);
                        float s = sq8(v0, v1); s += __shfl_xor(s, 16); s += __shfl_xor(s, 32); if (fq == 0) atomicAdd(ssq_c + row, s);
                    } else if (isrope) {
                        rope8(v0, v1, c4[m], s4[m]);
                        *(u32x4*)(KR + (size_t)row * 64 + (g - 256) + 8 * fq) = pack8(v0, v1);
                    } else {
                        *(u32x4*)(CQ + (size_t)row * 384 + (g - 320) + 8 * fq) = pack8(v0, v1);
                        float s = sq8(v0, v1); s += __shfl_xor(s, 16); s += __shfl_xor(s, 32); if (fq == 0) atomicAdd(ssq_q + row, s);
                    }
                }
                EPI_FENCE();
            }
        }
    }
};
template <bool ROPE192, int LDC> struct EpiLat {
    static constexpr bool PERM = true, AFTER_DRAIN = false;
    bf16_t* O; const float* ssq; float inv_kd; float scale; const float* cs; const float* sn;
    __device__ __forceinline__ void operator()(const f32x4 (&acc)[2][2][4][2], const Unit& u, int wr, int wc, int fr, int fq) const {
        const int row0 = u.pm * BM + wr * 64 + fr;
        float rs[2][4]; load_rs(rs, ssq, row0, inv_kd);
#pragma unroll
        for (int bj = 0; bj < 2; ++bj) {
            const int g = u.pn * BM + bj * HALF + wc * 32; const int hc = g % 192; const bool isrope = ROPE192 && hc >= 128;
#pragma unroll
            for (int ai = 0; ai < 2; ++ai) {
                f32x4 c4[4], s4[4];
                if (isrope) { const int j0 = ((hc - 128) >> 1) + 4 * fq;
#pragma unroll
                    for (int m = 0; m < 4; ++m) { const int pos = (row0 + ai * HALF + m * 16) & 4095; c4[m] = *(const f32x4*)(cs + pos * 32 + j0); s4[m] = *(const f32x4*)(sn + pos * 32 + j0); } }
#pragma unroll
                for (int m = 0; m < 4; ++m) {
                    const int row = row0 + ai * HALF + m * 16; const float r = rs[ai][m] * scale;
                    f32x4 v0 = acc[ai][bj][m][0] * r, v1 = acc[ai][bj][m][1] * r;
                    if (isrope) rope8(v0, v1, c4[m], s4[m]);
                    *(u32x4*)(O + (size_t)row * LDC + g + 8 * fq) = pack8(v0, v1);
                }
                EPI_FENCE();
            }
        }
    }
};
#undef EPI_FENCE
}
namespace att {
typedef unsigned short bf16_t;
typedef short bf16x8 __attribute__((ext_vector_type(8)));
typedef short s16x4 __attribute__((ext_vector_type(4)));
typedef float f32x16 __attribute__((ext_vector_type(16)));
typedef float f32x4 __attribute__((ext_vector_type(4)));
typedef unsigned u32x4 __attribute__((ext_vector_type(4)));
#define SBAR() __builtin_amdgcn_sched_barrier(0)
constexpr int SHM_V = 16384;
constexpr float THR = 8.f;
__device__ __forceinline__ int v_st(int k, int c) { const int kk = (k & ~0xC) | ((k & 4) << 1) | ((k & 8) >> 1); return ((kk >> 3) * 4 + (c >> 5)) * 512 + ((kk & 7) * 32 + (c & 31)) * 2; }
__device__ __forceinline__ int v_rd_base(int lane) { return ((lane & 3) << 3) | (((lane >> 2) & 3) << 6) | (((lane >> 4) & 1) << 5) | (((lane >> 5) & 1) << 8); }
__device__ __forceinline__ int crow(int r, int hi) { return (r & 3) + 8 * (r >> 2) + 4 * hi; }
typedef float f32x2_t __attribute__((ext_vector_type(2))); typedef __bf16 bf16x2_t __attribute__((ext_vector_type(2)));
__device__ __forceinline__ unsigned cvtpk(float lo, float hi) { f32x2_t v = {lo, hi}; bf16x2_t b = __builtin_convertvector(v, bf16x2_t); return __builtin_bit_cast(unsigned, b); }
template <int ROWB> __device__ __forceinline__ int kswz(int row, int colB) { return row * ROWB + (colB ^ ((row & (ROWB == 256 ? 15 : 7)) << 4)); }

__device__ __forceinline__ void mask_tile(f32x16& p0, f32x16& p1, int dq) {
    const float NEG = -__builtin_inff();
#pragma unroll
    for (int r = 0; r < 16; ++r) { const int c = (r & 3) + 8 * (r >> 2); if (dq - c < 0) p0[r] = NEG; if (dq - c - 32 < 0) p1[r] = NEG; }
}
template <int NQ, int ROWB>
__device__ __forceinline__ void qkt(f32x16& p0, f32x16& p1, const char* Kt, int cofs, int r32, int hi, const bf16x8* qr) {
    constexpr int GS = (NQ > 4) ? 2 : 4, NG = NQ / GS;
    const char* kb[4];
#pragma unroll
    for (int dd = 0; dd < 4; ++dd) kb[dd] = Kt + kswz<ROWB>(r32, cofs + (dd * 16 + hi * 8) * 2);
    bf16x8 kf[2][2 * GS];
#define KLD(g, bufi) do { _Pragma("unroll") for (int e = 0; e < GS; ++e) { const int d0_ = (g) * GS + e; const char* a_ = kb[d0_ & 3] + (d0_ >> 2) * 128; \
        kf[bufi][2 * e] = *reinterpret_cast<const bf16x8*>(a_); kf[bufi][2 * e + 1] = *reinterpret_cast<const bf16x8*>(a_ + 32 * ROWB); } } while (0)
    KLD(0, 0);
#pragma unroll
    for (int g = 0; g < NG; ++g) {
        if (g + 1 < NG) KLD(g + 1, (g + 1) & 1);
        SBAR();
#pragma unroll
        for (int e = 0; e < GS; ++e) {
            if (g == 0 && e == 0) { p0 = __builtin_amdgcn_mfma_f32_32x32x16_bf16(kf[0][0], qr[0], f32x16{}, 0, 0, 0); p1 = __builtin_amdgcn_mfma_f32_32x32x16_bf16(kf[0][1], qr[0], f32x16{}, 0, 0, 0); }
            else { p0 = __builtin_amdgcn_mfma_f32_32x32x16_bf16(kf[g & 1][2 * e], qr[g * GS + e], p0, 0, 0, 0); p1 = __builtin_amdgcn_mfma_f32_32x32x16_bf16(kf[g & 1][2 * e + 1], qr[g * GS + e], p1, 0, 0, 0); }
        }
        SBAR();
    }
#undef KLD
}
__device__ __forceinline__ void pv_tile(f32x16* o, int vb, bf16x8 pa0, bf16x8 pa1, bf16x8 pa2, bf16x8 pa3) {
#define TRRD(dst, off) asm volatile("ds_read_b64_tr_b16 %0, %1 offset:%2" : "=&v"(dst) : "v"(vb), "i"(off) : "memory")
#define PV_RD(X, d0) do { constexpr int b_ = (d0) * 512; \
        TRRD(X##l0, b_); TRRD(X##h0, b_ + 2048); TRRD(X##l1, b_ + 4096); TRRD(X##h1, b_ + 6144); TRRD(X##l2, b_ + 8192); TRRD(X##h2, b_ + 10240); TRRD(X##l3, b_ + 12288); TRRD(X##h3, b_ + 14336); } while (0)
#define PV_MM(X, d0) do { \
        o[d0] = __builtin_amdgcn_mfma_f32_32x32x16_bf16(pa0, (bf16x8){X##l0[0], X##l0[1], X##l0[2], X##l0[3], X##h0[0], X##h0[1], X##h0[2], X##h0[3]}, o[d0], 0, 0, 0); \
        o[d0] = __builtin_amdgcn_mfma_f32_32x32x16_bf16(pa1, (bf16x8){X##l1[0], X##l1[1], X##l1[2], X##l1[3], X##h1[0], X##h1[1], X##h1[2], X##h1[3]}, o[d0], 0, 0, 0); \
        o[d0] = __builtin_amdgcn_mfma_f32_32x32x16_bf16(pa2, (bf16x8){X##l2[0], X##l2[1], X##l2[2], X##l2[3], X##h2[0], X##h2[1], X##h2[2], X##h2[3]}, o[d0], 0, 0, 0); \
        o[d0] = __builtin_amdgcn_mfma_f32_32x32x16_bf16(pa3, (bf16x8){X##l3[0], X##l3[1], X##l3[2], X##l3[3], X##h3[0], X##h3[1], X##h3[2], X##h3[3]}, o[d0], 0, 0, 0); } while (0)
    s16x4 al0, al1, al2, al3, ah0, ah1, ah2, ah3, bl0, bl1, bl2, bl3, bh0, bh1, bh2, bh3;
    PV_RD(a, 0); PV_RD(b, 1);
    asm volatile("s_waitcnt lgkmcnt(8)" ::: "memory"); SBAR(); PV_MM(a, 0); SBAR();
    PV_RD(a, 2);
    asm volatile("s_waitcnt lgkmcnt(8)" ::: "memory"); SBAR(); PV_MM(b, 1); SBAR();
    PV_RD(b, 3);
    asm volatile("s_waitcnt lgkmcnt(8)" ::: "memory"); SBAR(); PV_MM(a, 2); SBAR();
    asm volatile("s_waitcnt lgkmcnt(0)" ::: "memory"); SBAR(); PV_MM(b, 3);
#undef PV_RD
#undef PV_MM
#undef TRRD
}
__device__ __forceinline__ void softmax_tile(f32x16& p0, f32x16& p1, float& m_reg, float& l_reg, f32x16* o, float* al_l, int r32, int hi,
                                             bf16x8& pa0, bf16x8& pa1, bf16x8& pa2, bf16x8& pa3) {
    float pmax = p0[0];
#pragma unroll
    for (int r = 1; r < 16; ++r) pmax = fmaxf(pmax, p0[r]);
#pragma unroll
    for (int r = 0; r < 16; ++r) pmax = fmaxf(pmax, p1[r]);
    { auto rr = __builtin_amdgcn_permlane32_swap(__float_as_uint(pmax), __float_as_uint(pmax), false, false);
      pmax = fmaxf(__uint_as_float(rr[0]), __uint_as_float(rr[1])); }
    if (!__all(pmax - m_reg <= THR)) {
        const float mn = fmaxf(m_reg, pmax); const float alpha = __builtin_amdgcn_exp2f(m_reg - mn); m_reg = mn; l_reg *= alpha;
        if (hi == 0) al_l[r32] = alpha;
        asm volatile("s_waitcnt lgkmcnt(0)" ::: "memory");
#pragma unroll
        for (int g = 0; g < 4; ++g) { const f32x4 a4 = *(const f32x4*)(al_l + 8 * g + 4 * hi);
#pragma unroll
            for (int d = 0; d < 4; ++d)
#pragma unroll
                for (int e = 0; e < 4; ++e) o[d][4 * g + e] *= a4[e]; }
    }
    float ps = 0.f;
#pragma unroll
    for (int r = 0; r < 16; ++r) { p0[r] = __builtin_amdgcn_exp2f(p0[r] - m_reg); ps += p0[r]; }
#pragma unroll
    for (int r = 0; r < 16; ++r) { p1[r] = __builtin_amdgcn_exp2f(p1[r] - m_reg); ps += p1[r]; }
    l_reg += ps;
#define PK4(P, B_, OUT) do { u32x4 w = {cvtpk(P[B_+0], P[B_+1]), cvtpk(P[B_+2], P[B_+3]), cvtpk(P[B_+4], P[B_+5]), cvtpk(P[B_+6], P[B_+7])}; OUT = *reinterpret_cast<bf16x8*>(&w); } while (0)
    PK4(p0, 0, pa0); PK4(p0, 8, pa1); PK4(p1, 0, pa2); PK4(p1, 8, pa3);
#undef PK4
}

template <int ROWB>
__device__ __forceinline__ void qk_sm_interleaved(f32x16& n0, f32x16& n1, f32x16& c0, f32x16& c1, const char* Kt, int cofs, int r32, int hi, const bf16x8* qr,
                                                  float& m_reg, float& l_reg, f32x16* o, float* al_l, bf16x8& pa0, bf16x8& pa1, bf16x8& pa2, bf16x8& pa3) {
    bf16x8 kf[8];
#pragma unroll
    for (int dd = 0; dd < 4; ++dd) { const char* a_ = Kt + kswz<ROWB>(r32, cofs + (dd * 16 + hi * 8) * 2);
        kf[2 * dd] = *reinterpret_cast<const bf16x8*>(a_); kf[2 * dd + 1] = *reinterpret_cast<const bf16x8*>(a_ + 32 * ROWB); }
    SBAR();
    n0 = __builtin_amdgcn_mfma_f32_32x32x16_bf16(kf[0], qr[0], f32x16{}, 0, 0, 0); n1 = __builtin_amdgcn_mfma_f32_32x32x16_bf16(kf[1], qr[0], f32x16{}, 0, 0, 0);
    SBAR();
    float pmax = c0[0];
#pragma unroll
    for (int r = 1; r < 16; ++r) pmax = fmaxf(pmax, c0[r]);
    SBAR();
    n0 = __builtin_amdgcn_mfma_f32_32x32x16_bf16(kf[2], qr[1], n0, 0, 0, 0); n1 = __builtin_amdgcn_mfma_f32_32x32x16_bf16(kf[3], qr[1], n1, 0, 0, 0);
    SBAR();
#pragma unroll
    for (int r = 0; r < 16; ++r) pmax = fmaxf(pmax, c1[r]);
    { auto rr = __builtin_amdgcn_permlane32_swap(__float_as_uint(pmax), __float_as_uint(pmax), false, false);
      pmax = fmaxf(__uint_as_float(rr[0]), __uint_as_float(rr[1])); }
    if (!__all(pmax - m_reg <= THR)) {
        const float mn = fmaxf(m_reg, pmax); const float alpha = __builtin_amdgcn_exp2f(m_reg - mn); m_reg = mn; l_reg *= alpha;
        if (hi == 0) al_l[r32] = alpha;
        asm volatile("s_waitcnt lgkmcnt(0)" ::: "memory");
#pragma unroll
        for (int g = 0; g < 4; ++g) { const f32x4 a4 = *(const f32x4*)(al_l + 8 * g + 4 * hi);
#pragma unroll
            for (int d = 0; d < 4; ++d)
#pragma unroll
                for (int e = 0; e < 4; ++e) o[d][4 * g + e] *= a4[e]; }
    }
    SBAR();
    n0 = __builtin_amdgcn_mfma_f32_32x32x16_bf16(kf[4], qr[2], n0, 0, 0, 0); n1 = __builtin_amdgcn_mfma_f32_32x32x16_bf16(kf[5], qr[2], n1, 0, 0, 0);
    SBAR();
    float ps = 0.f;
#pragma unroll
    for (int r = 0; r < 16; ++r) { c0[r] = __builtin_amdgcn_exp2f(c0[r] - m_reg); ps += c0[r]; }
    SBAR();
    n0 = __builtin_amdgcn_mfma_f32_32x32x16_bf16(kf[6], qr[3], n0, 0, 0, 0); n1 = __builtin_amdgcn_mfma_f32_32x32x16_bf16(kf[7], qr[3], n1, 0, 0, 0);
    SBAR();
#pragma unroll
    for (int r = 0; r < 16; ++r) { c1[r] = __builtin_amdgcn_exp2f(c1[r] - m_reg); ps += c1[r]; }
    l_reg += ps;
#define PK4(P, B_, OUT) do { u32x4 w = {cvtpk(P[B_+0], P[B_+1]), cvtpk(P[B_+2], P[B_+3]), cvtpk(P[B_+4], P[B_+5]), cvtpk(P[B_+6], P[B_+7])}; OUT = *reinterpret_cast<bf16x8*>(&w); } while (0)
    PK4(c0, 0, pa0); PK4(c0, 8, pa1); PK4(c1, 0, pa2); PK4(c1, 8, pa3);
#undef PK4
}
#define ATT_LAS __attribute__((address_space(3)))
template <int MODE>
__device__ __forceinline__ void attn_unit(char* lds, ATT_LAS unsigned char* lds3, const bf16_t* Qb, const bf16_t* Kb, const bf16_t* KRb, const bf16_t* Vb, bf16_t* Ob, int q0, float lam, const float* subg) {
    constexpr int QP = MODE ? 1536 : 3072, KP = MODE ? 2048 : 3072, VP = KP, OP = 1024, NQ = MODE ? 12 : 4, ROWB = MODE ? 384 : 256, UROWS = MODE ? 256 : 128, SHM_K = 64 * ROWB;
    constexpr int NKS = MODE ? 3 : 2;
    const int tid = threadIdx.x, wid = __builtin_amdgcn_readfirstlane(tid >> 6), lane = tid & 63, r32 = lane & 31, hi = lane >> 5;
    const int comp = MODE ? 0 : (wid & 1), rg = MODE ? wid : (wid >> 1);
    const int qrow0 = q0 + rg * 32;
    const int NT = (q0 + UROWS) / 64;
    char* V_lds = lds; char* K_lds = lds + 2 * SHM_V;
    float* wsf = (float*)(lds + 2 * SHM_V + 2 * SHM_K) + wid * 64; float* li_l = wsf; float* al_l = wsf + 32;
    const bf16_t* ksrc[NKS]; int kstr[NKS]; int voff[2];
#pragma unroll
    for (int j = 0; j < NKS; ++j) {
        if (MODE) { const int cidx = 64 * (wid * 3 + j) + lane, row = cidx / 24, pc = cidx - row * 24, lc = (pc & ~7) | ((pc & 7) ^ (row & 7));
            if (lc < 16) { ksrc[j] = Kb + (size_t)row * KP + lc * 8; kstr[j] = 64 * KP; } else { ksrc[j] = KRb + (size_t)row * 64 + (lc - 16) * 8; kstr[j] = 64 * 64; } }
        else { const int row = 4 * (wid * 2 + j) + (lane >> 4), pc = lane & 15, lc = pc ^ (row & 15); ksrc[j] = Kb + (size_t)row * KP + lc * 8; kstr[j] = 64 * KP; }
    }
#pragma unroll
    for (int j = 0; j < 2; ++j) { const int q = 64 * (wid * 2 + j) + lane, st = q >> 5, w = q & 31, kk = ((st >> 2) << 3) | (w >> 2);
        const int k = kk, c = (st & 3) * 32 + (w & 3) * 8; voff[j] = k * VP + c; }
#define DMA_K(t, bf) do { _Pragma("unroll") for (int j_ = 0; j_ < NKS; ++j_) \
        __builtin_amdgcn_global_load_lds((const unsigned*)(ksrc[j_] + (size_t)(t) * kstr[j_]), (ATT_LAS unsigned*)(lds3 + 2 * SHM_V + (bf) * SHM_K + (wid * NKS + j_) * 1024), 16, 0, 0); } while (0)
#define DMA_V(t, bf) do { _Pragma("unroll") for (int j_ = 0; j_ < 2; ++j_) \
        __builtin_amdgcn_global_load_lds((const unsigned*)(Vb + (size_t)(t) * 64 * VP + voff[j_]), (ATT_LAS unsigned*)(lds3 + (bf) * SHM_V + (wid * 2 + j_) * 1024), 16, 0, 0); } while (0)
    constexpr bool PIPE = (MODE == 0);
    DMA_K(0, 0); DMA_V(0, 0); if (PIPE) DMA_K(1, 1);
    bf16x8 qr[NQ];
#pragma unroll
    for (int d0 = 0; d0 < NQ; ++d0) qr[d0] = *reinterpret_cast<const bf16x8*>(Qb + (size_t)(qrow0 + r32) * QP + comp * 64 + d0 * 16 + hi * 8);
    const int vb0 = (int)(uintptr_t)V_lds + v_rd_base(lane);
    float m_reg = -1e30f, l_reg = 0.f; f32x16 o[4] = {};
#pragma unroll
    for (int d0 = 0; d0 < NQ; ++d0) asm volatile("" :: "v"(qr[d0]));
    asm volatile("s_waitcnt vmcnt(0)" ::: "memory");
    __syncthreads();
    f32x16 sA0, sA1, sB0, sB1;
    if (PIPE) qkt<NQ, ROWB>(sA0, sA1, K_lds, comp * 128, r32, hi, qr);
    if (PIPE) { asm volatile("s_waitcnt lgkmcnt(0)" ::: "memory"); __syncthreads(); }
#define STEP(C0, C1, N0, N1, t, P) do { \
        const int kb_ = (t) * 64; \
        if (PIPE) { if ((t) + 2 < NT) DMA_K((t) + 2, P); } else { if ((t) + 1 < NT) DMA_K((t) + 1, 1 - (P)); } \
        if ((t) + 1 < NT) DMA_V((t) + 1, 1 - (P)); \
        if (PIPE) { if ((t) + 1 < NT && kb_ + 64 <= qrow0 + 31) qkt<NQ, ROWB>(N0, N1, K_lds + (1 - (P)) * SHM_K, comp * 128, r32, hi, qr); } \
        if (kb_ <= qrow0 + 31) { bf16x8 pa0, pa1, pa2, pa3; \
            if (!PIPE) qkt<NQ, ROWB>(C0, C1, K_lds + (P) * SHM_K, comp * 128, r32, hi, qr); \
            if (kb_ + 63 > qrow0) mask_tile(C0, C1, qrow0 + r32 - kb_ - 4 * hi); \
            softmax_tile(C0, C1, m_reg, l_reg, o, al_l, r32, hi, pa0, pa1, pa2, pa3); \
            SBAR(); \
            pv_tile(o, vb0 + (P) * SHM_V, pa0, pa1, pa2, pa3); } \
        asm volatile("s_waitcnt vmcnt(0)" ::: "memory"); \
        __syncthreads(); } while (0)
#define ISTEP(C0, C1, N0, N1, t, P) do { bf16x8 pa0, pa1, pa2, pa3; \
        DMA_K((t) + 2, P); DMA_V((t) + 1, 1 - (P)); \
        qk_sm_interleaved<ROWB>(N0, N1, C0, C1, K_lds + (1 - (P)) * SHM_K, comp * 128, r32, hi, qr, m_reg, l_reg, o, al_l, pa0, pa1, pa2, pa3); \
        SBAR(); \
        pv_tile(o, vb0 + (P) * SHM_V, pa0, pa1, pa2, pa3); \
        asm volatile("s_waitcnt vmcnt(0)" ::: "memory"); \
        __syncthreads(); } while (0)
    if (PIPE) {
        const int NTI = NT - 2;
#pragma unroll 1
        for (int t = 0; t < NTI; t += 2) { ISTEP(sA0, sA1, sB0, sB1, t, 0); ISTEP(sB0, sB1, sA0, sA1, t + 1, 1); }
        STEP(sA0, sA1, sB0, sB1, NTI, 0); STEP(sB0, sB1, sA0, sA1, NTI + 1, 1);
    } else {
#pragma unroll 1
        for (int t = 0; t < NT; t += 2) { STEP(sA0, sA1, sA0, sA1, t, 0); STEP(sA0, sA1, sA0, sA1, t + 1, 1); }
    }
#undef ISTEP
#undef STEP
#undef DMA_K
#undef DMA_V
    { auto rr = __builtin_amdgcn_permlane32_swap(__float_as_uint(l_reg), __float_as_uint(l_reg), false, false); l_reg = __uint_as_float(rr[0]) + __uint_as_float(rr[1]); }
    if (hi == 0) li_l[r32] = l_reg;
    asm volatile("s_waitcnt lgkmcnt(0)" ::: "memory");
#pragma unroll
    for (int g = 0; g < 4; ++g) { const f32x4 l4 = *(const f32x4*)(li_l + 8 * g + 4 * hi);
#pragma unroll
        for (int e = 0; e < 4; ++e) { const float rl = __builtin_amdgcn_rcpf(l4[e]);
#pragma unroll
            for (int d = 0; d < 4; ++d) o[d][4 * g + e] *= rl; } }
    bf16_t* Ow = Ob + (size_t)qrow0 * OP;
    if (MODE) {
#pragma unroll
        for (int r = 0; r < 16; ++r) { const int orow = crow(r, hi);
#pragma unroll
            for (int d0 = 0; d0 < 4; ++d0) Ow[(size_t)orow * OP + d0 * 32 + r32] = (bf16_t)(cvtpk(o[d0][r], o[d0][r]) & 0xffffu); }
    } else {
        float* xb = (float*)lds + rg * 4096;
        if (comp == 1) {
#pragma unroll
            for (int d0 = 0; d0 < 4; ++d0)
#pragma unroll
                for (int r = 0; r < 16; ++r) xb[(d0 * 16 + r) * 64 + lane] = o[d0][r] * lam;
        }
        __syncthreads();
        if (comp == 0) {
            float s[16];
#pragma unroll
            for (int r = 0; r < 16; ++r) { float a = 0.f;
#pragma unroll
                for (int d0 = 0; d0 < 4; ++d0) { const float dv = o[d0][r] - xb[(d0 * 16 + r) * 64 + lane]; o[d0][r] = dv; a += dv * dv; }
                s[r] = a; }
#pragma unroll
            for (int off = 1; off < 32; off <<= 1)
#pragma unroll
                for (int r = 0; r < 16; ++r) s[r] += __shfl_xor(s[r], off);
            float gg[4];
#pragma unroll
            for (int d0 = 0; d0 < 4; ++d0) gg[d0] = subg[d0 * 32 + r32] * 0.8f;
#pragma unroll
            for (int r = 0; r < 16; ++r) { const int orow = crow(r, hi); const float rs = rsqrtf(s[r] * (1.0f / 128.0f) + 1e-5f);
#pragma unroll
                for (int d0 = 0; d0 < 4; ++d0) { const float v = o[d0][r] * rs * gg[d0]; Ow[(size_t)orow * OP + d0 * 32 + r32] = (bf16_t)(cvtpk(v, v) & 0xffffu); } }
        }
        __syncthreads();
    }
}
#undef SBAR
}
#ifndef MK_SINGLE
#define MK_SINGLE 1
#endif
constexpr int NWAVES = 8;
constexpr int BATCH = 8, SEQ = 4096, DM = 1024, M = BATCH * SEQ, FF = 4096;
constexpr int NQKV = 3072, NDKVQ = 768, KVL = 256, QL = 384, NUKV = 2048, NUQ = 1536;
constexpr int NPHASE = 13;
constexpr size_t MiB = 1u << 20;
constexpr size_t WS_WQKV = 2 * MiB, WS_WOA = 8 * MiB, WS_WUP0 = 10 * MiB, WS_WDN0 = 18 * MiB, WS_WDKVQ = 26 * MiB, WS_WUKV = 28 * MiB, WS_WUQ = 29 * MiB,
                 WS_WOB = 31 * MiB, WS_WUP1 = 33 * MiB, WS_WDN1 = 41 * MiB;
constexpr size_t WS_COS = 49 * MiB, WS_SIN = WS_COS + 512 * 1024, WS_SSQ = 50 * MiB;
constexpr size_t WS_HB = 64 * MiB;
constexpr size_t WS_R1 = 128 * MiB;
constexpr size_t WS_KV = WS_R1, WS_QB = WS_R1 + 128 * MiB, WS_CB = WS_R1 + 224 * MiB, WS_KR = WS_R1 + 240 * MiB;
constexpr size_t WS_O = 384 * MiB, WS_CQ = 448 * MiB, WS_END = 472 * MiB;
constexpr int RING_BYTES = 131072, LDS_BYTES = RING_BYTES + 2048;

#define LAS __attribute__((address_space(3)))
typedef unsigned short bf16;
#define RLX_AGENT __ATOMIC_RELAXED, __HIP_MEMORY_SCOPE_AGENT
#define XB_TMO      128
#define XB_XCNT(j)  (256  + 64 * (j))
#define XB_XSUB(j)  (1280 + 64 * (j))
#define XB_XGEN(j)  (2304 + 64 * (j))
#define XB_TOP      3328
#define XB_TOPGEN   3392
#define XCD_BAR_WORDS 3456
#define XB_SPIN_CAP (1u << 18)

__device__ __forceinline__ unsigned xb_ld(unsigned* p)              { return __hip_atomic_load(p, __ATOMIC_RELAXED, __HIP_MEMORY_SCOPE_AGENT); }
__device__ __forceinline__ unsigned xb_add(unsigned* p, unsigned v) { return __hip_atomic_fetch_add(p, v, __ATOMIC_RELAXED, __HIP_MEMORY_SCOPE_AGENT); }
__device__ __forceinline__ unsigned xb_xcc_id() { return (unsigned)__builtin_amdgcn_s_getreg((3 << 11) | 20) & 0xFu; }
#define XB_SPIN(cond, bar) do { unsigned _sp = 0; while (cond) { __builtin_amdgcn_s_sleep(1); \
    if ((++_sp & 255u) == 0u) { if (xb_ld(&(bar)[XB_TMO])) break; if (_sp > XB_SPIN_CAP) { atomicAdd(&(bar)[XB_TMO], 1u); break; } } } } while (0)

struct XcdBarrier {
    unsigned* bar; unsigned x;
    volatile LAS unsigned* st;
};

__device__ __forceinline__ XcdBarrier xcd_barrier_post(unsigned* bar, volatile LAS unsigned* st) {
    XcdBarrier b; b.bar = bar; b.x = xb_xcc_id(); b.st = st;
    if (threadIdx.x == 0) (void)xb_add(&bar[XB_XCNT(b.x)], 1u);
    return b;
}
__device__ __forceinline__ void xcd_barrier_complete(unsigned* bar, unsigned x, unsigned& nloc, unsigned& nx) {
    const unsigned G = gridDim.x * gridDim.y * gridDim.z;
    unsigned sum, cnt, mine, sp = 0u;
    for (;;) {
        sum = 0u; cnt = 0u; mine = 0u;
#pragma unroll
        for (unsigned j = 0; j < 16; ++j) { const unsigned c = xb_ld(&bar[XB_XCNT(j)]); sum += c; cnt += (c > 0u) ? 1u : 0u; mine = (j == x) ? c : mine; }
        if (sum == G) break;
        __builtin_amdgcn_s_sleep(1);
        if ((++sp & 255u) == 0u) { if (xb_ld(&bar[XB_TMO])) break; if (sp > XB_SPIN_CAP) { atomicAdd(&bar[XB_TMO], 1u); break; } }
    }
    nloc = mine > 0u ? mine : 1u; nx = cnt > 0u ? cnt : 1u;
}

__device__ __forceinline__ void xcd_barrier(const XcdBarrier& b) {
    asm volatile("s_waitcnt vmcnt(0)" ::: "memory");
    __syncthreads();
    if (threadIdx.x == 0) {
        unsigned* bar = b.bar;
        __builtin_amdgcn_s_waitcnt(0);
        unsigned nloc = b.st[0], nx = b.st[1];
        if (nloc == 0u) { xcd_barrier_complete(bar, b.x, nloc, nx); b.st[0] = nloc; b.st[1] = nx; }
        const unsigned old = xb_add(&bar[XB_XSUB(b.x)], 1u);
        const unsigned gen = old / nloc;
        if (old + 1u == (gen + 1u) * nloc) {
            __builtin_amdgcn_fence(__ATOMIC_RELEASE, "agent");
            asm volatile("s_waitcnt vmcnt(0)" ::: "memory");
            const unsigned og = xb_add(&bar[XB_TOP], 1u);
            const unsigned tg = og / nx;
            if (og + 1u == (tg + 1u) * nx) xb_add(&bar[XB_TOPGEN], 1u);
            else XB_SPIN(xb_ld(&bar[XB_TOPGEN]) == tg, bar);
            __builtin_amdgcn_fence(__ATOMIC_ACQUIRE, "agent");
            xb_add(&bar[XB_XGEN(b.x)], 1u);
            asm volatile("s_waitcnt vmcnt(0)" ::: "memory");
        } else {
            XB_SPIN(xb_ld(&bar[XB_XGEN(b.x)]) == gen, bar);
            __builtin_amdgcn_fence(__ATOMIC_ACQUIRE, "agent");
            asm volatile("s_waitcnt vmcnt(0)" ::: "memory");
        }
    }
    __syncthreads();
}

constexpr size_t WS_CNT = 1 * MiB + 65536;
constexpr size_t WS_BAR = 1 * MiB;
typedef unsigned v4u __attribute__((ext_vector_type(4)));
typedef float f32x4 __attribute__((ext_vector_type(4)));
__device__ __forceinline__ unsigned pk2(float lo, float hi) { return pg8::cvt_pk_bf16(lo, hi); }
__device__ __forceinline__ float wave_sum(float v) {
#pragma unroll
    for (int o = 1; o < 64; o <<= 1) v += __shfl_xor(v, o);
    return v;
}
__device__ __forceinline__ int src_col(int mode, int n) {
    if (mode == 1) { if (n < 2048) { const int i = n & 63; return (n & ~63) + ((i & 1) << 5) + (i >> 1); } return n; }
    if (mode == 2) { if (n >= 256) { const int i = n - 256; return 256 + ((i & 1) << 5) + (i >> 1); } return n; }
    if (mode == 3) { const int hd = n / 192, i = n - hd * 192; if (i >= 128) { const int j = i - 128; return hd * 192 + 128 + ((j & 1) << 5) + (j >> 1); } return n; }
    return n;
}
__device__ __forceinline__ void conv_item(const float* W, int K, int N, const float* gain, bf16* WT, int row_off, int mode, LAS float* scr, int item, int lane) {
    const int nblk = N / 32, kb = item / nblk, nb = item % nblk, k0 = 64 * kb, n0 = 32 * nb;
    const int sc_ = src_col(mode, n0 + (lane & 31));
#pragma unroll 16
    for (int i = 0; i < 32; ++i) { const int kk = 2 * i + (lane >> 5); float w = W[(size_t)(k0 + kk) * N + sc_]; if (gain) w *= gain[k0 + kk]; scr[kk * 33 + (lane & 31)] = w; }
    asm volatile("s_waitcnt lgkmcnt(0)" ::: "memory");
    const int c = lane & 7;
#pragma unroll
    for (int j = 0; j < 4; ++j) { const int n = (lane >> 3) + 8 * j; const LAS float* s = scr + (8 * c) * 33 + n;
        v4u o; o.x = pk2(s[0 * 33], s[1 * 33]); o.y = pk2(s[2 * 33], s[3 * 33]); o.z = pk2(s[4 * 33], s[5 * 33]); o.w = pk2(s[6 * 33], s[7 * 33]);
        *(v4u*)(WT + (size_t)(row_off + n0 + n) * K + k0 + 8 * c) = o; }
    asm volatile("s_waitcnt lgkmcnt(0)" ::: "memory");
}
__device__ __forceinline__ void conv_matrix(const float* W, int K, int N, const float* gain, bf16* WT, int row_off, int mode, LAS float* scr, int gw, int NGW, int lane) {
    const int nitems = (K / 64) * (N / 32);
    for (int it = gw; it < nitems; it += NGW) conv_item(W, K, N, gain, WT, row_off, mode, scr, it, lane);
}

struct Args { const float* in[21]; float* out; unsigned char* ws; float inv_freq[32]; int ph_lo, ph_hi; };

__global__ void __launch_bounds__(NWAVES * 64, 2) mk_fwd(Args args) {
    extern __shared__ __attribute__((aligned(16))) unsigned char lds[];
    cg::grid_group grid = cg::this_grid();
    const int tid = threadIdx.x, lane = tid & 63, wave = __builtin_amdgcn_readfirstlane(tid >> 6);
    const int G = gridDim.x, bx = blockIdx.x;
    const int vcu = (G % 8 == 0) ? (bx % 8) * (G / 8) + bx / 8 : bx;
    unsigned char* ws = args.ws;
    const float* x = args.in[0]; float* out = args.out;
    bf16* Wqkv = (bf16*)(ws + WS_WQKV); bf16* Woa = (bf16*)(ws + WS_WOA); bf16* Wup0 = (bf16*)(ws + WS_WUP0); bf16* Wdn0 = (bf16*)(ws + WS_WDN0);
    bf16* Wdkvq = (bf16*)(ws + WS_WDKVQ); bf16* Wukv = (bf16*)(ws + WS_WUKV); bf16* Wuq = (bf16*)(ws + WS_WUQ); bf16* Wob = (bf16*)(ws + WS_WOB);
    bf16* Wup1 = (bf16*)(ws + WS_WUP1); bf16* Wdn1 = (bf16*)(ws + WS_WDN1);
    float* COS = (float*)(ws + WS_COS); float* SIN = (float*)(ws + WS_SIN);
    float* SSQ = (float*)(ws + WS_SSQ);
    bf16* HB = (bf16*)(ws + WS_HB); bf16* QKV = (bf16*)(ws + WS_R1); bf16* U = (bf16*)(ws + WS_R1);
    bf16* KVb = (bf16*)(ws + WS_KV); bf16* QB = (bf16*)(ws + WS_QB); bf16* CB = (bf16*)(ws + WS_CB); bf16* KR = (bf16*)(ws + WS_KR);
    bf16* OB = (bf16*)(ws + WS_O); bf16* CQ = (bf16*)(ws + WS_CQ);
    const int lo = args.ph_lo, hi_ = args.ph_hi;
#ifndef PHMASK
#define PHMASK 0x1fff
#endif
#define IN(k) ((((PHMASK) >> (k)) & 1) && lo <= (k) && (k) < hi_)
#ifndef DUPMASK
#define DUPMASK 0
#endif
#define NREP(k) (1 + (((DUPMASK) >> (k)) & 1))
#ifndef SYNCDUP
#define SYNCDUP 1
#endif
#define SEAM(k) do { if (IN(k) && IN((k) + 1)) { for (int s_ = 0; s_ < SYNCDUP; ++s_) { xcd_barrier(bar); } } } while (0)
    LAS unsigned char* lds3 = (LAS unsigned char*)lds;
    volatile LAS unsigned* MISC = (volatile LAS unsigned*)(lds3 + RING_BYTES + 1024);
    if (tid < 2) MISC[tid] = 0u;
    __syncthreads();
    XcdBarrier bar; bar.bar = (unsigned*)(ws + WS_BAR); bar.x = 0; bar.st = MISC;
    if (args.ph_hi - args.ph_lo > 1) bar = xcd_barrier_post((unsigned*)(ws + WS_BAR), MISC);
    if (args.ph_lo > 4096) grid.sync();
    constexpr float LOG2E = 1.4426950408889634f;

    for (int rep0_ = 0; rep0_ < NREP(0); ++rep0_) if (IN(0)) {
        LAS float* scr = (LAS float*)(lds3 + wave * 16384);
        const int gw = vcu * NWAVES + wave, NGW = G * NWAVES;
        {
            constexpr int I0 = (DM / 64) * (NQKV / 32), I1 = I0 + (DM / 64) * (DM / 32), I2 = I1 + (DM / 64) * (FF / 32), I3 = I2 + (FF / 64) * (DM / 32),
                          I4 = I3 + (DM / 64) * (320 / 32), I5 = I4 + (DM / 64) * (QL / 32), I6 = I5 + (KVL / 64) * (NUKV / 32), I7 = I6 + (QL / 64) * (NUQ / 32),
                          I8 = I7 + (DM / 64) * (DM / 32), I9 = I8 + (DM / 64) * (FF / 32), I10 = I9 + (FF / 64) * (DM / 32);
            for (int it = gw; it < I10; it += NGW) {
                if (it < I0) conv_item(args.in[2], DM, NQKV, args.in[1], Wqkv, 0, 1, scr, it, lane);
                else if (it < I1) conv_item(args.in[8], DM, DM, nullptr, Woa, 0, 0, scr, it - I0, lane);
                else if (it < I2) conv_item(args.in[18], DM, FF, args.in[17], Wup0, 0, 0, scr, it - I1, lane);
                else if (it < I3) conv_item(args.in[19], FF, DM, nullptr, Wdn0, 0, 0, scr, it - I2, lane);
                else if (it < I4) conv_item(args.in[10], DM, 320, args.in[9], Wdkvq, 0, 2, scr, it - I3, lane);
                else if (it < I5) conv_item(args.in[13], DM, QL, args.in[1] + DM, Wdkvq, 320, 0, scr, it - I4, lane);
                else if (it < I6) conv_item(args.in[12], KVL, NUKV, args.in[11], Wukv, 0, 0, scr, it - I5, lane);
                else if (it < I7) conv_item(args.in[15], QL, NUQ, args.in[14], Wuq, 0, 3, scr, it - I6, lane);
                else if (it < I8) conv_item(args.in[16], DM, DM, nullptr, Wob, 0, 0, scr, it - I7, lane);
                else if (it < I9) conv_item(args.in[18] + (size_t)DM * FF, DM, FF, args.in[17] + DM, Wup1, 0, 0, scr, it - I8, lane);
                else conv_item(args.in[19] + (size_t)FF * DM, FF, DM, nullptr, Wdn1, 0, 0, scr, it - I9, lane);
            }
        }
        const int gt = bx * (NWAVES * 64) + tid, NGT = G * NWAVES * 64;
        for (int i = gt; i < 64 * DM / 8; i += NGT) ((v4u*)(Wdkvq + (size_t)704 * DM))[i] = (v4u){0u, 0u, 0u, 0u};
        for (int i = gt; i < SEQ * 32; i += NGT) {
            const int pos = i >> 5, j = i & 31; const float ang = (float)pos * args.inv_freq[j];
            double rev = (double)ang * 0.15915494309189535; rev -= floor(rev); const float fr = (float)rev;
            COS[i] = __builtin_amdgcn_cosf(fr); SIN[i] = __builtin_amdgcn_sinf(fr); }
        for (int i = gt; i < 6 * M; i += NGT) SSQ[M + i] = 0.f;
        for (int m = gw; m < M; m += 2 * NGW) {
            const int m2 = m + NGW;
            const bool has2 = m2 < M;
            const f32x4* xr = (const f32x4*)(x + (size_t)m * DM) + lane; const f32x4* xr2 = (const f32x4*)(x + (size_t)(has2 ? m2 : m) * DM) + lane;
            f32x4 v[4], w[4]; float s = 0.f, s2 = 0.f;
#pragma unroll
            for (int j = 0; j < 4; ++j) { v[j] = xr[64 * j]; w[j] = xr2[64 * j]; }
#pragma unroll
            for (int j = 0; j < 4; ++j) { s += (v[j].x * v[j].x + v[j].y * v[j].y) + (v[j].z * v[j].z + v[j].w * v[j].w); s2 += (w[j].x * w[j].x + w[j].y * w[j].y) + (w[j].z * w[j].z + w[j].w * w[j].w); }
            s = wave_sum(s); s2 = wave_sum(s2);
            if (lane == 0) { SSQ[m] = s; if (has2) SSQ[m2] = s2; }
            unsigned long long* o8 = (unsigned long long*)(HB + (size_t)m * DM) + lane; unsigned long long* o82 = (unsigned long long*)(HB + (size_t)(has2 ? m2 : m) * DM) + lane;
#pragma unroll
            for (int j = 0; j < 4; ++j) { o8[64 * j] = (unsigned long long)pk2(v[j].x, v[j].y) | ((unsigned long long)pk2(v[j].z, v[j].w) << 32);
                if (has2) o82[64 * j] = (unsigned long long)pk2(w[j].x, w[j].y) | ((unsigned long long)pk2(w[j].z, w[j].w) << 32); }
        }
    }
    SEAM(0);
    if (IN(1)) {
        pg8::Gemm g{HB, Wqkv, M, NQKV, DM}; pg8::StaticOrder S; S.init(M, NQKV, G, bx); S.rep = NREP(1);
        pg8::EpiQKV E{QKV, SSQ, COS, SIN, 0.125f * LOG2E};
        pg8::gemm_phase<pg8::EpiQKV, pg8::StaticOrder, true, true>(lds3, g, S, E);
    }
    SEAM(1);
    if (IN(2)) {
        const float a1 = wave_sum(args.in[3][lane] * args.in[4][lane]), a2 = wave_sum(args.in[5][lane] * args.in[6][lane]);
        const float lam = __expf(a1) - __expf(a2) + 0.2f;
        for (int slot = vcu; slot < 256; slot += G) {
            const int xcd = slot >> 5, i = slot & 31;
            for (int r_ = 0; r_ < 8 * NREP(2); ++r_) { const int r = r_ & 7;
                const int bh = 8 * xcd + r, qb = (r & 1) ? i : 31 - i, b = bh >> 3, h = bh & 7;
                const bf16* base = QKV + (size_t)b * SEQ * NQKV;
                att::attn_unit<0>((char*)lds, lds3, base + h * 128, base + 1024 + h * 128, nullptr, base + 2048 + h * 128, OB + (size_t)b * SEQ * DM + h * 128, qb * 128, lam, args.in[7]);
            }
        }
    }
    SEAM(2);
    if (IN(3)) {
        pg8::Gemm g{OB, Woa, M, DM, DM}; pg8::StaticOrder S; S.init(M, DM, G, bx);
        pg8::EpiRes E{HB, SSQ + M};
        pg8::gemm_phase<pg8::EpiRes, pg8::StaticOrder, true, true>(lds3, g, S, E);
    }
    SEAM(3);
    if (IN(4)) {
        pg8::Gemm g{HB, Wup0, M, FF, DM}; pg8::StaticOrder S; S.init(M, FF, G, bx); S.rep = NREP(4);
        pg8::EpiUp E{U, SSQ + M};
        pg8::gemm_phase<pg8::EpiUp, pg8::StaticOrder, true, true>(lds3, g, S, E);
    }
    SEAM(4);
    if (IN(5)) {
        pg8::Gemm g{U, Wdn0, M, DM, FF}; pg8::StaticOrder S; S.init(M, DM, G, bx);
        pg8::EpiRes E{HB, SSQ + 2 * M};
        pg8::gemm_phase<pg8::EpiRes, pg8::StaticOrder, true, true>(lds3, g, S, E);
    }
    SEAM(5);
    if (IN(6)) {
        pg8::Gemm g{HB, Wdkvq, M, NDKVQ, DM}; pg8::StaticOrder S; S.init(M, NDKVQ, G, bx);
        pg8::EpiDkvq E{CB, KR, CQ, SSQ + 2 * M, SSQ + 5 * M, SSQ + 6 * M, COS, SIN};
        pg8::gemm_phase<pg8::EpiDkvq, pg8::StaticOrder, true, true>(lds3, g, S, E);
    }
    SEAM(6);
    if (IN(7)) {
        { pg8::Gemm g{CB, Wukv, M, NUKV, KVL}; pg8::StaticOrder S; S.init(M, NUKV, G, bx); S.rep = NREP(7);
          pg8::EpiLat<false, NUKV> E{KVb, SSQ + 5 * M, 1.0f / 256.0f, 1.0f, COS, SIN};
          pg8::gemm_phase<pg8::EpiLat<false, NUKV>, pg8::StaticOrder, true, true>(lds3, g, S, E); }
        { pg8::Gemm g{CQ, Wuq, M, NUQ, QL}; pg8::StaticOrder S; S.init(M, NUQ, G, bx); S.rep = NREP(7);
          pg8::EpiLat<true, NUQ> E{QB, SSQ + 6 * M, 1.0f / 384.0f, 0.07216878364870322f * LOG2E, COS, SIN};
          pg8::gemm_phase<pg8::EpiLat<true, NUQ>, pg8::StaticOrder, true, true>(lds3, g, S, E); }
    }
    SEAM(7);
    if (IN(8)) {
        for (int slot = vcu; slot < 256; slot += G) {
            const int xcd = slot >> 5, i = slot & 31, j = i & 15, gsel = i >> 4;
            for (int r_ = 0; r_ < 4 * NREP(8); ++r_) { const int r = r_ & 3;
                const int bh = 8 * xcd + 4 * (r >> 1) + 2 * gsel + (r & 1), qb = (r & 1) ? j : 15 - j, b = bh >> 3, h = bh & 7;
                att::attn_unit<1>((char*)lds, lds3, QB + (size_t)b * SEQ * NUQ + h * 192, KVb + (size_t)b * SEQ * NUKV + h * 256, KR + (size_t)b * SEQ * 64,
                                  KVb + (size_t)b * SEQ * NUKV + h * 256 + 128, OB + (size_t)b * SEQ * DM + h * 128, qb * 256, 0.f, nullptr);
            }
        }
    }
    SEAM(8);
    if (IN(9)) {
        pg8::Gemm g{OB, Wob, M, DM, DM}; pg8::StaticOrder S; S.init(M, DM, G, bx);
        pg8::EpiRes E{HB, SSQ + 3 * M};
        pg8::gemm_phase<pg8::EpiRes, pg8::StaticOrder, true, true>(lds3, g, S, E);
    }
    SEAM(9);
    if (IN(10)) {
        pg8::Gemm g{HB, Wup1, M, FF, DM}; pg8::StaticOrder S; S.init(M, FF, G, bx); S.rep = NREP(10);
        pg8::EpiUp E{U, SSQ + 3 * M};
        pg8::gemm_phase<pg8::EpiUp, pg8::StaticOrder, true, true>(lds3, g, S, E);
    }
    SEAM(10);
    if (IN(11)) {
        pg8::Gemm g{U, Wdn1, M, DM, FF}; pg8::StaticOrder S; S.init(M, DM, G, bx);
        pg8::EpiResFinal E{HB, SSQ + 4 * M, (unsigned*)(ws + WS_CNT), out, args.in[20]};
        pg8::gemm_phase<pg8::EpiResFinal, pg8::StaticOrder, true, true>(lds3, g, S, E);
    }
    if (false) {
        const int gw = vcu * NWAVES + wave, NGW = G * NWAVES; const float* fg = args.in[20];
        f32x4 gv[4];
#pragma unroll
        for (int j = 0; j < 2; ++j) { gv[2 * j] = ((const f32x4*)fg)[128 * j + 2 * lane]; gv[2 * j + 1] = ((const f32x4*)fg)[128 * j + 2 * lane + 1]; }
        for (int m = gw; m < M; m += NGW) {
            const float rs = rsqrtf(SSQ[4 * M + m] * (1.0f / 1024.0f) + 1e-6f);
            const v4u* hr = (const v4u*)(HB + (size_t)m * DM); f32x4* orow = (f32x4*)(out + (size_t)m * DM);
#pragma unroll
            for (int j = 0; j < 2; ++j) { const v4u w = hr[64 * j + lane];
                const f32x4 a = (f32x4){__uint_as_float(w.x << 16), __uint_as_float(w.x & 0xffff0000u), __uint_as_float(w.y << 16), __uint_as_float(w.y & 0xffff0000u)};
                const f32x4 b = (f32x4){__uint_as_float(w.z << 16), __uint_as_float(w.z & 0xffff0000u), __uint_as_float(w.w << 16), __uint_as_float(w.w & 0xffff0000u)};
                orow[128 * j + 2 * lane] = a * rs * gv[2 * j]; orow[128 * j + 2 * lane + 1] = b * rs * gv[2 * j + 1]; }
        }
    }
#undef IN
#undef SEAM
}

extern "C" void kernel_launch(void* const* d_in, const int* in_sizes, int n_in, void* d_out, int out_size, void* d_ws, size_t ws_size, hipStream_t stream) {
    static int grid = 0;
    if (grid == 0) {
        if (n_in != 21 || in_sizes[0] != M * DM || out_size != M * DM || ws_size < WS_END) {
            fprintf(stderr, "kernel_launch: unexpected shapes (n_in %d, in0 %d, out %d, ws %zu); nothing launched\n", n_in, n_in > 0 ? in_sizes[0] : -1, out_size, ws_size); grid = -1; return; }
        int dev = 0, cus = 0, per_cu = 0;
        (void)hipGetDevice(&dev); (void)hipDeviceGetAttribute(&cus, hipDeviceAttributeMultiprocessorCount, dev);
        if (hipFuncSetAttribute((const void*)mk_fwd, hipFuncAttributeMaxDynamicSharedMemorySize, LDS_BYTES) != hipSuccess) { fprintf(stderr, "kernel_launch: hipFuncSetAttribute failed\n"); grid = -1; return; }
        if (hipOccupancyMaxActiveBlocksPerMultiprocessor(&per_cu, (const void*)mk_fwd, NWAVES * 64, LDS_BYTES) != hipSuccess || per_cu < 1) { fprintf(stderr, "kernel_launch: occupancy query says %d\n", per_cu); per_cu = 1; }
        (void)hipGetLastError();
        if (cus <= 0) cus = 256;
        grid = cus * 1;
    }
    if (grid < 0) return;
    Args a{};
    for (int i = 0; i < 21; ++i) a.in[i] = (const float*)d_in[i];
    a.out = (float*)d_out; a.ws = (unsigned char*)d_ws;
    for (int j = 0; j < 32; ++j) a.inv_freq[j] = powf(10000.0f, -((float)(2 * j)) / 64.0f);
#if MK_SINGLE
    a.ph_lo = 0; a.ph_hi = NPHASE;
    if (hipMemsetAsync((char*)d_ws + WS_BAR, 0, 65536 + 128 * 256, stream) != hipSuccess) { fprintf(stderr, "kernel_launch: hipMemsetAsync failed\n"); return; }
    void* kargs[] = {&a};
    hipError_t e = hipLaunchCooperativeKernel((const void*)mk_fwd, dim3(grid), dim3(NWAVES * 64), kargs, LDS_BYTES, stream);
    if (e != hipSuccess) fprintf(stderr, "kernel_launch: cooperative launch failed: %s (grid %d)\n", hipGetErrorString(e), grid);
#else
    for (int p = 0; p < NPHASE; ++p) { a.ph_lo = p; a.ph_hi = p + 1; hipLaunchKernelGGL(mk_fwd, dim3(grid), dim3(NWAVES * 64), LDS_BYTES, stream, a); }
#endif
}
```
